# Optimizing an MI355X kernel written in HIP

```python
import math
import jax
import jax.numpy as jnp
from jax import lax
import numpy as np

D_MODEL = 1024
BATCH = 4
SEQ = 4096
DEPTH = 4

N_MIXERS = 3
N_ATTN = (DEPTH + 2) // 3
N_SSM = (DEPTH + 1) // 3
N_GMLP = DEPTH // 3

DA_HEADS = 8
DA_HEAD_DIM = D_MODEL // (2 * DA_HEADS)
DA_V_DIM = 2 * DA_HEAD_DIM
Q_BLOCK = 128
ROPE_THETA = 10000.0

S5_GROUP = 16
S5_GROUPS = D_MODEL // S5_GROUP
S5_STATE = 64
DT_MIN = 1e-3
DT_MAX = 1e-1

GM_FFN = 6 * D_MODEL
GM_HALF = GM_FFN // 2
GM_HEADS = 8
GM_HEAD_DIM = GM_HALF // GM_HEADS
GM_CHUNK = 128

MLP_HIDDEN = 4 * D_MODEL
EPS = 1e-6

kernel_name = "hybrid_diffattn_s5_gmlp_trunk"


def rms_norm(x, gain):
    x32 = x.astype(jnp.float32)
    y = x32 * lax.rsqrt(jnp.mean(jnp.square(x32), axis=-1, keepdims=True) + EPS)
    return (y * gain.astype(jnp.float32)).astype(x.dtype)


def rope_tables(positions):
    inv_freq = ROPE_THETA ** (-jnp.arange(0, DA_HEAD_DIM, 2, dtype=jnp.float32) / DA_HEAD_DIM)
    ang = positions.astype(jnp.float32)[..., None] * inv_freq
    return jnp.cos(ang), jnp.sin(ang)


def apply_rope(x, cos, sin):
    x32 = x.astype(jnp.float32)
    c = cos[:, :, None, None, :]
    s = sin[:, :, None, None, :]
    x1, x2 = jnp.split(x32, 2, axis=-1)
    return jnp.concatenate([x1 * c - x2 * s, x2 * c + x1 * s], axis=-1).astype(x.dtype)


def diff_attention(h, cos, sin, w_qkv, q_gain, k_gain, lam, sub_gain, w_o, lambda_init):
    B, L, _ = h.shape
    qkv = h @ w_qkv
    q, k, v = jnp.split(qkv, 3, axis=-1)
    q = q.reshape(B, L, DA_HEADS, 2, DA_HEAD_DIM)
    k = k.reshape(B, L, DA_HEADS, 2, DA_HEAD_DIM)
    v = v.reshape(B, L, DA_HEADS, DA_V_DIM)
    q = apply_rope(rms_norm(q, q_gain), cos, sin)
    k = apply_rope(rms_norm(k, k_gain), cos, sin)
    lam32 = lam.astype(jnp.float32)
    lam_full = (jnp.exp(jnp.sum(lam32[0] * lam32[1])) - jnp.exp(jnp.sum(lam32[2] * lam32[3]))
                + lambda_init)
    n_blocks = L // Q_BLOCK
    q_blocks = jnp.moveaxis(q.reshape(B, n_blocks, Q_BLOCK, DA_HEADS, 2, DA_HEAD_DIM), 1, 0)
    key_pos = jnp.arange(L)
    scale = DA_HEAD_DIM ** -0.5

    def block(args):
        qb, blk = args
        q_pos = blk * Q_BLOCK + jnp.arange(Q_BLOCK)
        s = jnp.einsum('bqhcd,bkhcd->bhcqk', qb, k,
                       preferred_element_type=jnp.float32) * scale
        s = jnp.where(key_pos[None, :] <= q_pos[:, None], s, -jnp.inf)
        p = jax.nn.softmax(s, axis=-1)
        a = p[:, :, 0] - lam_full * p[:, :, 1]
        return jnp.einsum('bhqk,bkhe->bqhe', a.astype(v.dtype), v)

    o = lax.map(block, (q_blocks, jnp.arange(n_blocks)))
    o = jnp.moveaxis(o, 0, 1).reshape(B, L, DA_HEADS, DA_V_DIM)
    o = rms_norm(o, sub_gain) * (1.0 - lambda_init)
    return o.reshape(B, L, D_MODEL) @ w_o


def _linear_recurrence(e_i, e_j):
    a_i, b_i = e_i
    a_j, b_j = e_j
    return a_j * a_i, a_j * b_i + b_j


def s5_mixer(h, w_in, a_re, a_im, b_re, b_im, c_re, c_im, d_skip, log_dt, w_glu, b_glu, w_out):
    B, L, _ = h.shape
    f32 = jnp.float32
    u = h @ w_in
    lam = lax.complex(jnp.minimum(a_re.astype(f32), -1e-4), a_im.astype(f32))
    dt = jnp.exp(log_dt.astype(f32))[:, None]
    lam_bar = jnp.exp(lam * dt)
    zoh = (lam_bar - 1.0) / lam
    b_cplx = lax.complex(b_re.astype(f32), b_im.astype(f32))
    b_bar = zoh[..., None] * b_cplx
    ug = u.astype(f32).reshape(B, L, S5_GROUPS, S5_GROUP)
    bu = lax.complex(jnp.einsum('blgh,gph->blgp', ug, jnp.real(b_bar)),
                     jnp.einsum('blgh,gph->blgp', ug, jnp.imag(b_bar)))
    a_elems = jnp.broadcast_to(lam_bar, (1, L, S5_GROUPS, S5_STATE))
    _, states = lax.associative_scan(_linear_recurrence, (a_elems, bu), axis=1)
    y = (jnp.einsum('ghp,blgp->blgh', c_re.astype(f32), jnp.real(states))
         - jnp.einsum('ghp,blgp->blgh', c_im.astype(f32), jnp.imag(states)))
    y = y.reshape(B, L, D_MODEL) + d_skip.astype(f32) * u.astype(f32)
    g = jax.nn.gelu(y.astype(h.dtype))
    g = g * jax.nn.sigmoid(g @ w_glu + b_glu)
    return g @ w_out


def gmlp_mixer(h, w_in, v_gain, w_s, b_s, w_out):
    B, L, _ = h.shape
    z = jax.nn.gelu(h @ w_in)
    u, v = jnp.split(z, 2, axis=-1)
    v = rms_norm(v, v_gain)
    n_chunks = L // GM_CHUNK
    v = v.reshape(B, n_chunks, GM_CHUNK, GM_HEADS, GM_HEAD_DIM)
    causal = jnp.tril(jnp.ones((GM_CHUNK, GM_CHUNK), dtype=bool))
    w_masked = jnp.where(causal[None], w_s, 0.0).astype(v.dtype)
    gate = (jnp.einsum('hts,bcshd->bcthd', w_masked, v)
            + b_s.T.astype(v.dtype)[None, None, :, :, None])
    gate = gate.reshape(B, L, GM_HALF)
    return (u * gate) @ w_out


def squared_relu_mlp(h, w1, w2):
    return jnp.square(jax.nn.relu(h @ w1)) @ w2


def setup_inputs(seed: int = 0) -> dict:
    key = jax.random.key(seed)
    ks = jax.random.split(key, 30)
    f32 = jnp.float32

    def dense(k, shape, fan_in):
        return jax.random.normal(k, shape, f32) * fan_in ** -0.5

    def gain(k, shape):
        return 1.0 + 0.02 * jax.random.normal(k, shape, f32)

    x = jax.random.normal(ks[0], (BATCH, SEQ, D_MODEL), f32)
    offset = jax.random.randint(ks[1], (BATCH, 1), 0, 2048, dtype=jnp.int32)
    positions = offset + jnp.arange(SEQ, dtype=jnp.int32)[None, :]
    n = jnp.arange(S5_STATE, dtype=f32)
    a_shape = (N_SSM, S5_GROUPS, S5_STATE)
    return {
        'x': x,
        'positions': positions,
        'norm_mix': gain(ks[2], (DEPTH, D_MODEL)),
        'norm_mlp': gain(ks[3], (DEPTH, D_MODEL)),
        'mlp_w1': dense(ks[4], (DEPTH, D_MODEL, MLP_HIDDEN), D_MODEL),
        'mlp_w2': dense(ks[5], (DEPTH, MLP_HIDDEN, D_MODEL), MLP_HIDDEN),
        'attn_w_qkv': dense(ks[6], (N_ATTN, D_MODEL, 3 * D_MODEL), D_MODEL),
        'attn_q_norm': gain(ks[7], (N_ATTN, DA_HEAD_DIM)),
        'attn_k_norm': gain(ks[8], (N_ATTN, DA_HEAD_DIM)),
        'attn_lambda': 0.1 * jax.random.normal(ks[9], (N_ATTN, 4, DA_HEAD_DIM), f32),
        'attn_sub_norm': gain(ks[10], (N_ATTN, DA_V_DIM)),
        'attn_w_o': dense(ks[11], (N_ATTN, D_MODEL, D_MODEL), D_MODEL),
        'ssm_w_in': dense(ks[12], (N_SSM, D_MODEL, D_MODEL), D_MODEL),
        'ssm_a_re': -0.5 + 0.01 * jax.random.normal(ks[13], a_shape, f32),
        'ssm_a_im': math.pi * n + 0.01 * jax.random.normal(ks[14], a_shape, f32),
        'ssm_b_re': dense(ks[15], (N_SSM, S5_GROUPS, S5_STATE, S5_GROUP), 2 * S5_GROUP),
        'ssm_b_im': dense(ks[16], (N_SSM, S5_GROUPS, S5_STATE, S5_GROUP), 2 * S5_GROUP),
        'ssm_c_re': 0.5 * jax.random.normal(ks[17], (N_SSM, S5_GROUPS, S5_GROUP, S5_STATE), f32),
        'ssm_c_im': 0.5 * jax.random.normal(ks[18], (N_SSM, S5_GROUPS, S5_GROUP, S5_STATE), f32),
        'ssm_d': jax.random.normal(ks[19], (N_SSM, D_MODEL), f32),
        'ssm_log_dt': jax.random.uniform(ks[20], (N_SSM, S5_GROUPS), f32,
                                         minval=math.log(DT_MIN), maxval=math.log(DT_MAX)),
        'ssm_w_glu': dense(ks[21], (N_SSM, D_MODEL, D_MODEL), D_MODEL),
        'ssm_b_glu': 0.02 * jax.random.normal(ks[22], (N_SSM, D_MODEL), f32),
        'ssm_w_out': dense(ks[23], (N_SSM, D_MODEL, D_MODEL), D_MODEL),
        'gm_w_in': dense(ks[24], (N_GMLP, D_MODEL, GM_FFN), D_MODEL),
        'gm_v_norm': gain(ks[25], (N_GMLP, GM_HALF)),
        'gm_w_s': dense(ks[26], (N_GMLP, GM_HEADS, GM_CHUNK, GM_CHUNK), GM_CHUNK),
        'gm_b_s': 1.0 + 0.1 * jax.random.normal(ks[27], (N_GMLP, GM_HEADS, GM_CHUNK), f32),
        'gm_w_out': dense(ks[28], (N_GMLP, GM_HALF, D_MODEL), GM_HALF),
    }


def reference(x, positions, norm_mix, norm_mlp, mlp_w1, mlp_w2,
              attn_w_qkv, attn_q_norm, attn_k_norm, attn_lambda, attn_sub_norm, attn_w_o,
              ssm_w_in, ssm_a_re, ssm_a_im, ssm_b_re, ssm_b_im, ssm_c_re, ssm_c_im,
              ssm_d, ssm_log_dt, ssm_w_glu, ssm_b_glu, ssm_w_out,
              gm_w_in, gm_v_norm, gm_w_s, gm_b_s, gm_w_out):
    cos, sin = rope_tables(positions)
    for i in range(DEPTH):
        kind = i % N_MIXERS
        j = i // N_MIXERS
        h = rms_norm(x, norm_mix[i])
        if kind == 0:
            lambda_init = 0.8 - 0.6 * math.exp(-0.3 * i)
            m = diff_attention(h, cos, sin, attn_w_qkv[j], attn_q_norm[j], attn_k_norm[j],
                               attn_lambda[j], attn_sub_norm[j], attn_w_o[j], lambda_init)
        elif kind == 1:
            m = s5_mixer(h, ssm_w_in[j], ssm_a_re[j], ssm_a_im[j], ssm_b_re[j], ssm_b_im[j],
                         ssm_c_re[j], ssm_c_im[j], ssm_d[j], ssm_log_dt[j],
                         ssm_w_glu[j], ssm_b_glu[j], ssm_w_out[j])
        else:
            m = gmlp_mixer(h, gm_w_in[j], gm_v_norm[j], gm_w_s[j], gm_b_s[j], gm_w_out[j])
        x = x + m
        x = x + squared_relu_mlp(rms_norm(x, norm_mlp[i]), mlp_w1[i], mlp_w2[i])
    return x
```

```cpp
#include <hip/hip_runtime.h>
#include <hip/hip_bf16.h>
#include <cstdio>
#include <cstdint>
#include <cmath>

constexpr int BATCH = 4, SEQ = 4096, DM_ = 1024, T_ = BATCH * SEQ;
constexpr int FF = 4096, GF = 6144, GH = 3072;
constexpr float EPS_ = 1e-6f;

__device__ __forceinline__ int tid_fresh() { int t = threadIdx.x; asm volatile("" : "+v"(t)); return t; }

namespace pg8 {
#define PG8_LAS __attribute__((address_space(3)))
typedef unsigned short bf16_t;
typedef short bf16x8 __attribute__((ext_vector_type(8)));
typedef float f32x4 __attribute__((ext_vector_type(4)));
typedef unsigned u32x4 __attribute__((ext_vector_type(4)));
constexpr int BM = 256, BK = 64, HALF = 128, HTB = HALF * BK * 2  , STAGE_BYTES = 8 * HTB, NXCD = 8, WGM = 8;

__host__ __device__ __forceinline__ int lds_byte(int r, int c) { const int st = (r >> 4) * 2 + (c >> 5), rr = r & 15, cc = c & 31, ob = rr * 64 + cc * 2; return st * 1024 + (ob ^ (((ob >> 9) & 1) << 5)); }
__host__ __device__ __forceinline__ void stage_rc(int b, int& R, int& C) { const int st = b / 1024, sb = b % 1024, swz = sb ^ (((sb >> 9) & 1) << 5); R = (st >> 1) * 16 + swz / 64; C = (st & 1) * 32 + (swz % 64) / 2; }
__host__ __device__ __forceinline__ int perm32(int rho) { const int n = rho >> 4, i = rho & 15; return 8 * (i >> 2) + 4 * n + (i & 3); }

struct Unit { int pm, pn; };
struct Gemm { const bf16_t* A; const bf16_t* Bt; int M, N, K; };

struct StaticOrder {
    int nM, nN, nwg, G, c;
    __host__ __device__ void init(int M, int N, int G_, int c_) { nM = M / BM; nN = N / BM; nwg = nM * nN; G = G_; c = c_; }
    __host__ __device__ bool next(int i, Unit& u) const {
        const long L = (long)i * G + c; if (L >= nwg) return false;
        int wgid = (int)L; { const int q = nwg / NXCD, r = nwg % NXCD, xcd = wgid % NXCD, off = wgid / NXCD; wgid = (xcd < r ? xcd * (q + 1) : r * (q + 1) + (xcd - r) * q) + off; }
        const int nig = WGM * nN, gid = wgid / nig, fm = gid * WGM, gsz = (nM - fm) < WGM ? (nM - fm) : WGM;
        u.pm = fm + ((wgid % nig) % gsz); u.pn = (wgid % nig) / gsz; return true;
    }
    __device__ __forceinline__ void a_ready(const Unit&) const {}
    __device__ __forceinline__ void done(const Unit&) const {}
};

__device__ __forceinline__ unsigned cvt_pk_bf16(float lo, float hi) { unsigned r; asm volatile("v_cvt_pk_bf16_f32 %0, %1, %2" : "=v"(r) : "v"(lo), "v"(hi)); return r; }
typedef float f32x2 __attribute__((ext_vector_type(2)));
__device__ __forceinline__ float bf2f(unsigned short h) { return __uint_as_float((unsigned)h << 16); }
__device__ __forceinline__ float gelu_tanh(float x) {
    const float z2 = 1.5957691216057308f * (x + 0.044715f * x * x * x);
    return x * __builtin_amdgcn_rcpf(1.0f + __builtin_amdgcn_exp2f(-1.4426950408889634f * z2)); }
__device__ __forceinline__ float sigmoidf_(float a) { return __builtin_amdgcn_rcpf(1.0f + __builtin_amdgcn_exp2f(-1.4426950408889634f * a)); }
__device__ __forceinline__ float rs_of(float ssq) { return __builtin_amdgcn_rsqf(ssq * (1.0f / 1024.0f) + 1e-6f); }
__device__ __forceinline__ float slab16_sum(const float* slab, int row) { const f32x4* p = (const f32x4*)(slab + (size_t)row * 16); const f32x4 a = p[0], b = p[1], c = p[2], d = p[3];
    return (((a[0] + a[1]) + (a[2] + a[3])) + ((b[0] + b[1]) + (b[2] + b[3]))) + (((c[0] + c[1]) + (c[2] + c[3])) + ((d[0] + d[1]) + (d[2] + d[3]))); }
__device__ __forceinline__ u32x4 pack8(const f32x4 v0, const f32x4 v1) { u32x4 w; w.x = cvt_pk_bf16(v0[0], v0[1]); w.y = cvt_pk_bf16(v0[2], v0[3]); w.z = cvt_pk_bf16(v1[0], v1[1]); w.w = cvt_pk_bf16(v1[2], v1[3]); return w; }

template <int ACT, bool SLAB> struct EpiRowScale {
    static constexpr bool PERM = true, AFTER_DRAIN = false;
    bf16_t* O; int ldc; const float* ssq;
    __device__ __forceinline__ void operator()(const f32x4 (&acc)[2][2][4][2], const Unit& u, int wr, int wc, int fr, int fq) const {
        const int row0 = u.pm * BM + wr * 64 + fr, col0 = u.pn * BM + wc * 32 + 8 * fq;
#pragma unroll
        for (int ai = 0; ai < 2; ++ai)
#pragma unroll
            for (int m = 0; m < 4; ++m) { const int row = row0 + ai * HALF + m * 16; const float rsr = rs_of(SLAB ? slab16_sum(ssq, row) : ssq[row]); bf16_t* rowp = O + (size_t)row * ldc + col0;
#pragma unroll
                for (int bj = 0; bj < 2; ++bj) { f32x4 v0 = acc[ai][bj][m][0] * rsr, v1 = acc[ai][bj][m][1] * rsr;
#pragma unroll
                    for (int e = 0; e < 4; ++e) {
                        if (ACT == 1) { const float a = fmaxf(v0[e], 0.f), b = fmaxf(v1[e], 0.f); v0[e] = a * a; v1[e] = b * b; }
                        if (ACT == 2) { v0[e] = gelu_tanh(v0[e]); v1[e] = gelu_tanh(v1[e]); } }
                    *(u32x4*)(rowp + bj * HALF) = pack8(v0, v1); } }
    }
};
struct EpiGmV {
    static constexpr bool PERM = true, AFTER_DRAIN = false;
    bf16_t* O; int ldc; const float* ssq; float* ssqv;
    __device__ __forceinline__ void operator()(const f32x4 (&acc)[2][2][4][2], const Unit& u, int wr, int wc, int fr, int fq) const {
        const int row0 = u.pm * BM + wr * 64 + fr, col0 = u.pn * BM + wc * 32 + 8 * fq;
        float rsv[2][8], part[2][8];
#pragma unroll
        for (int bj = 0; bj < 2; ++bj) { const f32x4 s0 = *(const f32x4*)(ssq + col0 + bj * HALF), s1 = *(const f32x4*)(ssq + col0 + bj * HALF + 4);
#pragma unroll
            for (int e = 0; e < 4; ++e) { rsv[bj][e] = rs_of(s0[e]); rsv[bj][4 + e] = rs_of(s1[e]); part[bj][e] = 0.f; part[bj][4 + e] = 0.f; } }
#pragma unroll
        for (int ai = 0; ai < 2; ++ai)
#pragma unroll
            for (int m = 0; m < 4; ++m) { const int row = row0 + ai * HALF + m * 16; bf16_t* rowp = O + (size_t)row * ldc + col0;
#pragma unroll
                for (int bj = 0; bj < 2; ++bj) { f32x4 v0, v1;
#pragma unroll
                    for (int e = 0; e < 4; ++e) { v0[e] = gelu_tanh(acc[ai][bj][m][0][e] * rsv[bj][e]); v1[e] = gelu_tanh(acc[ai][bj][m][1][e] * rsv[bj][4 + e]);
                        part[bj][e] += v0[e] * v0[e]; part[bj][4 + e] += v1[e] * v1[e]; }
                    *(u32x4*)(rowp + bj * HALF) = pack8(v0, v1); } }
#pragma unroll
        for (int bj = 0; bj < 2; ++bj)
#pragma unroll
            for (int e = 0; e < 8; ++e) { float p = part[bj][e]; p += __shfl_xor(p, 1); p += __shfl_xor(p, 2); p += __shfl_xor(p, 4); p += __shfl_xor(p, 8);
                if (fr == 0) ssqv[(size_t)(col0 + bj * HALF + e) * 24 + 2 * u.pm + wr] = p; }
    }
};
struct EpiGlu {
    static constexpr bool PERM = true, AFTER_DRAIN = false;
    bf16_t* O; const bf16_t* G; const float* bias;
    __device__ __forceinline__ void operator()(const f32x4 (&acc)[2][2][4][2], const Unit& u, int wr, int wc, int fr, int fq) const {
        const int row0 = u.pm * BM + wr * 64 + fr, col0 = u.pn * BM + wc * 32 + 8 * fq;
        f32x4 bv[2][2];
#pragma unroll
        for (int bj = 0; bj < 2; ++bj) { bv[bj][0] = *(const f32x4*)(bias + col0 + bj * HALF); bv[bj][1] = *(const f32x4*)(bias + col0 + bj * HALF + 4); }
#pragma unroll
        for (int ai = 0; ai < 2; ++ai)
#pragma unroll
            for (int m = 0; m < 4; ++m) { const size_t off = (size_t)(row0 + ai * HALF + m * 16) * 1024 + col0;
#pragma unroll
                for (int bj = 0; bj < 2; ++bj) { const u32x4 gw = *(const u32x4*)(G + off + bj * HALF); f32x4 v0, v1;
#pragma unroll
                    for (int e = 0; e < 4; ++e) { const unsigned w0 = gw[e >> 1], w1 = gw[2 + (e >> 1)];
                        const float g0 = (e & 1) ? __uint_as_float(w0 & 0xffff0000u) : __uint_as_float(w0 << 16), g1 = (e & 1) ? __uint_as_float(w1 & 0xffff0000u) : __uint_as_float(w1 << 16);
                        v0[e] = g0 * sigmoidf_(acc[ai][bj][m][0][e] + bv[bj][0][e]); v1[e] = g1 * sigmoidf_(acc[ai][bj][m][1][e] + bv[bj][1][e]); }
                    *(u32x4*)(O + off + bj * HALF) = pack8(v0, v1); }
                asm volatile("" ::: "memory"); }
    }
};
struct EpiRes {
    static constexpr bool PERM = true, AFTER_DRAIN = false;
    const float* base; float* out; bf16_t* xb; float* ssq;
    __device__ __forceinline__ void operator()(const f32x4 (&acc)[2][2][4][2], const Unit& u, int wr, int wc, int fr, int fq) const {
        const int row0 = u.pm * BM + wr * 64 + fr, col0 = u.pn * BM + wc * 32 + 8 * fq;
#pragma unroll
        for (int ai = 0; ai < 2; ++ai)
#pragma unroll
            for (int m = 0; m < 4; ++m) { const int row = row0 + ai * HALF + m * 16; const size_t off = (size_t)row * 1024 + col0; float ss = 0.f;
#pragma unroll
                for (int bj = 0; bj < 2; ++bj) { const f32x4 b0 = *(const f32x4*)(base + off + bj * HALF), b1 = *(const f32x4*)(base + off + bj * HALF + 4);
                    const f32x4 o0 = b0 + acc[ai][bj][m][0], o1 = b1 + acc[ai][bj][m][1];
                    *(f32x4*)(out + off + bj * HALF) = o0; *(f32x4*)(out + off + bj * HALF + 4) = o1;
                    ss += (o0[0] * o0[0] + o0[1] * o0[1]) + (o0[2] * o0[2] + o0[3] * o0[3]) + (o1[0] * o1[0] + o1[1] * o1[1]) + (o1[2] * o1[2] + o1[3] * o1[3]);
                    *(u32x4*)(xb + off + bj * HALF) = pack8(o0, o1); }
                ss += __shfl_xor(ss, 16); ss += __shfl_xor(ss, 32);
                if (ssq != nullptr && fq == 0) ssq[(size_t)row * 16 + 4 * u.pn + wc] = ss;
                asm volatile("" ::: "memory"); }
    }
};
struct EpiQKV {
    static constexpr bool PERM = true, AFTER_DRAIN = false;
    bf16_t* Q; bf16_t* K; bf16_t* V; const float* ssq; const float* qg; const float* kg; const float* rope;
    __device__ __forceinline__ void operator()(const f32x4 (&acc)[2][2][4][2], const Unit& u, int wr, int wc, int fr, int fq) const {
        const int row0 = u.pm * BM + wr * 64 + fr; const int sect = u.pn >> 2, pnl = u.pn & 3; const int colb = pnl * 256 + wc * 64 + 8 * fq;
        if (sect == 2) {
#pragma unroll
            for (int ai = 0; ai < 2; ++ai)
#pragma unroll
                for (int m = 0; m < 4; ++m) { const int row = row0 + ai * HALF + m * 16; const float rsr = rs_of(ssq[row]); bf16_t* rowp = V + (size_t)row * 1024 + colb;
#pragma unroll
                    for (int bj = 0; bj < 2; ++bj) *(u32x4*)(rowp + bj * 32) = pack8(acc[ai][bj][m][0] * rsr, acc[ai][bj][m][1] * rsr); }
        } else {
            const float* gn = sect == 0 ? qg : kg; bf16_t* dst = sect == 0 ? Q : K; const float osc = sect == 0 ? 0.125f * 1.4426950408889634f : 1.0f;
            float g[2][8];
#pragma unroll
            for (int bj = 0; bj < 2; ++bj) { const f32x4 a = *(const f32x4*)(gn + bj * 32 + 8 * fq), b = *(const f32x4*)(gn + bj * 32 + 8 * fq + 4);
#pragma unroll
                for (int e = 0; e < 4; ++e) { g[bj][e] = a[e]; g[bj][4 + e] = b[e]; } }
#pragma unroll
            for (int ai = 0; ai < 2; ++ai)
#pragma unroll
                for (int m = 0; m < 4; ++m) { const int row = row0 + ai * HALF + m * 16; const float rsr = rs_of(ssq[row]);
                    float x[2][8]; float ss = 0.f;
#pragma unroll
                    for (int bj = 0; bj < 2; ++bj)
#pragma unroll
                        for (int e = 0; e < 8; ++e) { x[bj][e] = acc[ai][bj][m][e >> 2][e & 3] * rsr; ss += x[bj][e] * x[bj][e]; }
                    ss += __shfl_xor(ss, 16); ss += __shfl_xor(ss, 32);
                    const float r = __builtin_amdgcn_rsqf(ss * (1.0f / 64.0f) + 1e-6f) ;
                    const float* cs = rope + (size_t)row * 64 + 16 * fq;
                    const f32x4 c0 = *(const f32x4*)(cs), c1 = *(const f32x4*)(cs + 4), c2 = *(const f32x4*)(cs + 8), c3 = *(const f32x4*)(cs + 12);
                    const float co[8] = {c0[0], c0[2], c1[0], c1[2], c2[0], c2[2], c3[0], c3[2]}, si[8] = {c0[1], c0[3], c1[1], c1[3], c2[1], c2[3], c3[1], c3[3]};
                    f32x4 o1a, o1b, o2a, o2b;
#pragma unroll
                    for (int e = 0; e < 8; ++e) { const float x1 = x[0][e] * r * g[0][e], x2 = x[1][e] * r * g[1][e];
                        const float a = (x1 * co[e] - x2 * si[e]) * osc, b = (x2 * co[e] + x1 * si[e]) * osc;
                        if (e < 4) { o1a[e] = a; o2a[e] = b; } else { o1b[e - 4] = a; o2b[e - 4] = b; } }
                    bf16_t* rowp = dst + (size_t)row * 1024 + colb;
                    *(u32x4*)(rowp) = pack8(o1a, o1b); *(u32x4*)(rowp + 32) = pack8(o2a, o2b);
                    asm volatile("" ::: "memory"); }
        }
    }
};

template <class Epi, class Sched, bool ALIGN_EPI = false, bool SP2 = false>
__device__ __forceinline__ void gemm_phase(PG8_LAS unsigned char* lds, const Gemm g, const Sched& S, const Epi& E) {
    const int tid = tid_fresh(), wid = __builtin_amdgcn_readfirstlane(tid >> 6), lane = tid & 63, wr = wid >> 2, wc = wid & 3, fr = lane & 15, fq = lane >> 4;
    const int K = g.K, nt = K / BK;
    unsigned voffA[2], voffB[2];
#pragma unroll
    for (int i = 0; i < 2; ++i) { int R, C; stage_rc(tid * 16 + i * 8192, R, C); const int Rb = Epi::PERM ? ((R & ~31) + perm32(R & 31)) : R;
        voffA[i] = (unsigned)(R * K + C) * 2u; voffB[i] = (unsigned)(Rb * K + C) * 2u; }
    const size_t kstep = (size_t)(BK * 2);
    const size_t hstep = (size_t)HALF * K * 2;
    const size_t tstep = 2 * hstep;
    const unsigned ldsw = (unsigned)wid * 1024u;
    const int aoff = lds_byte(wr * 64 + fr, fq * 8), boff = lds_byte(wc * 32 + fr, fq * 8);
#define PG8_SA(b, h) (((b) * 2 + (h)) * HTB)
#define PG8_SB(b, h) ((4 + (b) * 2 + (h)) * HTB)
#define PG8_STAGE(bufoff, gbase, voff) do { _Pragma("unroll") for (int _i = 0; _i < 2; ++_i) \
        __builtin_amdgcn_global_load_lds((const unsigned*)((const char*)(gbase) + (voff)[_i]), (PG8_LAS unsigned*)(lds + (bufoff) + ldsw + _i * 8192), 16, 0, 0); } while (0)
#define PG8_LDA(dst, b, h) do { _Pragma("unroll") for (int m = 0; m < 4; ++m) _Pragma("unroll") for (int k = 0; k < 2; ++k) dst[m][k] = *(const PG8_LAS bf16x8*)(lds + PG8_SA(b, h) + aoff + m * 2048 + k * 1024); } while (0)
#define PG8_LDB(dst, b, h) do { _Pragma("unroll") for (int n = 0; n < 2; ++n) _Pragma("unroll") for (int k = 0; k < 2; ++k) dst[n][k] = *(const PG8_LAS bf16x8*)(lds + PG8_SB(b, h) + boff + n * 2048 + k * 1024); } while (0)
#define PG8_MMA(ai, bj, At, Bt) do { __builtin_amdgcn_s_setprio(1); _Pragma("unroll") for (int m = 0; m < 4; ++m) _Pragma("unroll") for (int n = 0; n < 2; ++n) _Pragma("unroll") for (int k = 0; k < 2; ++k) \
        acc[ai][bj][m][n] = __builtin_amdgcn_mfma_f32_16x16x32_bf16(Bt[n][k], At[m][k], acc[ai][bj][m][n], 0, 0, 0); __builtin_amdgcn_s_setprio(0); } while (0)
#define PG8_WAIT_V(n) asm volatile("s_waitcnt vmcnt(" #n ")" ::: "memory")
#define PG8_WAIT_L(n) asm volatile("s_waitcnt lgkmcnt(" #n ")" ::: "memory")
#define PG8_BAR __builtin_amdgcn_s_barrier()
#define PG8_SCHED __builtin_amdgcn_sched_barrier(0)
    Unit cur, nxt; int ui = 0;
    if (!S.next(0, cur)) return;
    f32x4 acc[2][2][4][2];
#pragma unroll
    for (int a = 0; a < 2; ++a)
#pragma unroll
        for (int b = 0; b < 2; ++b)
#pragma unroll
            for (int m = 0; m < 4; ++m)
#pragma unroll
                for (int n = 0; n < 2; ++n) acc[a][b][m][n] = (f32x4){0.f, 0.f, 0.f, 0.f};
    bf16x8 At[4][2], B0[2][2], B1[2][2];
    const char* cA = (const char*)g.A + (size_t)cur.pm * tstep; const char* cB = (const char*)g.Bt + (size_t)cur.pn * tstep;
    S.a_ready(cur);
    if constexpr (SP2) {
        PG8_STAGE(PG8_SB(0, 0), cB, voffB); PG8_STAGE(PG8_SB(0, 1), cB + hstep, voffB); PG8_STAGE(PG8_SA(0, 0), cA, voffA); PG8_STAGE(PG8_SA(0, 1), cA + hstep, voffA);
        if (wr == 1) PG8_BAR;
        PG8_WAIT_V(2); PG8_BAR;
        PG8_STAGE(PG8_SB(1, 0), cB + kstep, voffB); PG8_STAGE(PG8_SA(1, 0), cA + kstep, voffA); PG8_STAGE(PG8_SB(1, 1), cB + hstep + kstep, voffB);
        PG8_WAIT_V(6); PG8_BAR;
    } else {
        PG8_STAGE(PG8_SB(0, 0), cB, voffB); PG8_STAGE(PG8_SA(0, 0), cA, voffA); PG8_STAGE(PG8_SB(0, 1), cB + hstep, voffB); PG8_STAGE(PG8_SA(0, 1), cA + hstep, voffA);
        if (wr == 1) PG8_BAR;
        PG8_WAIT_V(4); PG8_BAR;
        PG8_STAGE(PG8_SB(1, 0), cB + kstep, voffB); PG8_STAGE(PG8_SA(1, 0), cA + kstep, voffA); PG8_STAGE(PG8_SB(1, 1), cB + hstep + kstep, voffB);
        PG8_WAIT_V(6); PG8_BAR;
    }
    for (;;) {
        const bool has_next = S.next(ui + 1, nxt);
        const char* nA = has_next ? (const char*)g.A + (size_t)nxt.pm * tstep : cA; const char* nB = has_next ? (const char*)g.Bt + (size_t)nxt.pn * tstep : cB;
        for (int t = 0; t < nt; t += 2) {
            const bool last = (t == nt - 2);
            const char* a1 = cA + (size_t)(t + 1) * kstep;
            const char* a2 = last ? nA : cA + (size_t)(t + 2) * kstep; const char* b2 = last ? nB : cB + (size_t)(t + 2) * kstep;
            const char* a3 = a2 + kstep; const char* b3 = b2 + kstep;
            if (last && has_next) S.a_ready(nxt);
            if constexpr (SP2) {
            PG8_LDB(B0, 0, 0); PG8_LDB(B1, 0, 1); PG8_SCHED; PG8_LDA(At, 0, 0); PG8_STAGE(PG8_SA(1, 1), a1 + hstep, voffA);
            PG8_WAIT_V(8); PG8_WAIT_L(0); PG8_BAR; PG8_MMA(0, 0, At, B0); PG8_MMA(0, 1, At, B1); PG8_BAR; PG8_SCHED;
            PG8_LDA(At, 0, 1); PG8_STAGE(PG8_SB(0, 0), b2, voffB); PG8_STAGE(PG8_SB(0, 1), b2 + hstep, voffB); PG8_STAGE(PG8_SA(0, 0), a2, voffA);
            PG8_WAIT_V(8); PG8_WAIT_L(0); PG8_BAR; PG8_MMA(1, 0, At, B0); PG8_MMA(1, 1, At, B1); PG8_BAR; PG8_SCHED;
            PG8_LDB(B0, 1, 0); PG8_LDB(B1, 1, 1); PG8_SCHED; PG8_LDA(At, 1, 0); PG8_STAGE(PG8_SA(0, 1), a2 + hstep, voffA);
            PG8_WAIT_V(8); PG8_WAIT_L(0); PG8_BAR; PG8_MMA(0, 0, At, B0); PG8_MMA(0, 1, At, B1); PG8_BAR; PG8_SCHED;
            PG8_LDA(At, 1, 1); PG8_STAGE(PG8_SB(1, 0), b3, voffB); PG8_STAGE(PG8_SB(1, 1), b3 + hstep, voffB); PG8_STAGE(PG8_SA(1, 0), a3, voffA);
            PG8_WAIT_V(8); PG8_WAIT_L(0); PG8_BAR; PG8_MMA(1, 0, At, B0); PG8_MMA(1, 1, At, B1); PG8_BAR; PG8_SCHED;
            } else {
            PG8_LDB(B0, 0, 0); PG8_SCHED; PG8_LDA(At, 0, 0); PG8_STAGE(PG8_SA(1, 1), a1 + hstep, voffA);
            PG8_WAIT_L(8); PG8_BAR; PG8_WAIT_L(0); PG8_MMA(0, 0, At, B0); PG8_BAR; PG8_SCHED;
            PG8_LDB(B1, 0, 1); PG8_STAGE(PG8_SB(0, 0), b2, voffB);
            PG8_BAR; PG8_WAIT_L(0); PG8_MMA(0, 1, At, B1); PG8_BAR;
            PG8_LDA(At, 0, 1); PG8_STAGE(PG8_SA(0, 0), a2, voffA);
            PG8_BAR; PG8_WAIT_L(0); PG8_MMA(1, 0, At, B0); PG8_BAR; PG8_SCHED;
            PG8_STAGE(PG8_SB(0, 1), b2 + hstep, voffB);
            PG8_WAIT_V(6); PG8_BAR; PG8_MMA(1, 1, At, B1); PG8_BAR;
            PG8_LDB(B0, 1, 0); PG8_SCHED; PG8_LDA(At, 1, 0); PG8_STAGE(PG8_SA(0, 1), a2 + hstep, voffA);
            PG8_WAIT_L(8); PG8_BAR; PG8_WAIT_L(0); PG8_MMA(0, 0, At, B0); PG8_BAR; PG8_SCHED;
            PG8_LDB(B1, 1, 1); PG8_STAGE(PG8_SB(1, 0), b3, voffB);
            PG8_BAR; PG8_WAIT_L(0); PG8_MMA(0, 1, At, B1); PG8_BAR;
            PG8_LDA(At, 1, 1); PG8_STAGE(PG8_SA(1, 0), a3, voffA);
            PG8_BAR; PG8_WAIT_L(0); PG8_MMA(1, 0, At, B0); PG8_BAR; PG8_SCHED;
            PG8_STAGE(PG8_SB(1, 1), b3 + hstep, voffB);
            PG8_WAIT_V(6); PG8_BAR; PG8_MMA(1, 1, At, B1); PG8_BAR;
            }
        }
        if constexpr (ALIGN_EPI) { if (wr == 0) PG8_BAR; }
        if constexpr (!Epi::AFTER_DRAIN) { E(acc, cur, wr, wc, fr, fq); S.done(cur); }
        if (!has_next) break;
#pragma unroll
        for (int a = 0; a < 2; ++a)
#pragma unroll
            for (int b = 0; b < 2; ++b)
#pragma unroll
                for (int m = 0; m < 4; ++m)
#pragma unroll
                    for (int n = 0; n < 2; ++n) acc[a][b][m][n] = (f32x4){0.f, 0.f, 0.f, 0.f};
        cur = nxt; cA = nA; cB = nB; ++ui;
        if constexpr (ALIGN_EPI) { if (wr == 1) PG8_BAR; }
    }
    PG8_WAIT_V(0);
    if constexpr (!ALIGN_EPI) { if (wr == 0) PG8_BAR; }
    PG8_BAR;
    if constexpr (Epi::AFTER_DRAIN) { E.fused(acc, cur, wr, wc, fr, fq, lds, wid, lane); S.done(cur); }
#undef PG8_SA
#undef PG8_SB
#undef PG8_STAGE
#undef PG8_LDA
#undef PG8_LDB
#undef PG8_MMA
#undef PG8_WAIT_V
#undef PG8_WAIT_L
#undef PG8_BAR
#undef PG8_SCHED
}
}
#ifndef PG8_SP2
#define PG8_SP2 true
#endif
#include <hip/hip_bf16.h>
#include <cmath>
namespace attn_body {
using bf16=__hip_bfloat16;
using bf16x8=__attribute__((ext_vector_type(8)))short;
using s16x4=__attribute__((ext_vector_type(4)))short;
using f32x16=__attribute__((ext_vector_type(16)))float;
using u32x4=__attribute__((ext_vector_type(4)))unsigned;
constexpr int BATCH=4,NHEAD=16,SEQ=4096,D=64,DM=NHEAD*D;
constexpr int NW=8,QBLK=32,QB=QBLK*NW,KVBLK=64,NQB=SEQ/QB;
constexpr int ATTN_PITCH=DM, ATTN_UNIT_ROWS=QB;
__device__ __forceinline__ int crow(int r,int hi){return (r&3)+8*(r>>2)+4*hi;}
#define SBAR() __builtin_amdgcn_sched_barrier(0)
__device__ __forceinline__ void cmask(f32x16&p0,f32x16&p1,int jb,int qrel,int hi){
  const float NEG=-INFINITY; int kb=64*jb+4*hi;
  #pragma unroll
  for(int r=0;r<16;++r){int kv=kb+(r&3)+8*(r>>2); if(kv>qrel)p0[r]=NEG; if(kv+32>qrel)p1[r]=NEG;}
}

constexpr int NSLOT=3, SLOTB=8192;
constexpr int LDS_K=0, LDS_V=NSLOT*SLOTB, LDS_WS=2*NSLOT*SLOTB, LDS_OST=LDS_WS+NW*64*4, LDS_BYTES=LDS_OST+NW*4096;
constexpr float C2=0.125f*1.4426950408889634f;
__device__ __forceinline__ void glds16(const void*gsrc,unsigned lds_dst){unsigned keep;
  asm volatile("s_mov_b32 %0, m0\n\ts_mov_b32 m0, %2\n\ts_nop 0\n\tglobal_load_lds_dwordx4 %1, off\n\ts_mov_b32 m0, %0":"=&s"(keep):"v"(gsrc),"s"(lds_dst):"memory");}
__device__ __forceinline__ float max3f(float a,float b,float c){float r;asm("v_max3_f32 %0, %1, %2, %3":"=v"(r):"v"(a),"v"(b),"v"(c));return r;}
__device__ __forceinline__ float max2f(float a,float b){float r;asm("v_max_f32_e32 %0, %1, %2":"=v"(r):"v"(a),"v"(b));return r;}
__device__ __forceinline__ float fadd_s(float a,float b){float r;asm("v_add_f32_e32 %0, %1, %2":"=v"(r):"v"(a),"v"(b));return r;}
__device__ __forceinline__ float fsub_s(float a,float b){float r;asm("v_sub_f32_e32 %0, %1, %2":"=v"(r):"v"(a),"v"(b));return r;}
typedef float f32x2_t __attribute__((ext_vector_type(2))); typedef __bf16 bf16x2_t __attribute__((ext_vector_type(2)));
__device__ __forceinline__ unsigned cvtpk_s(float lo,float hi){f32x2_t v={lo,hi};bf16x2_t b=__builtin_convertvector(v,bf16x2_t);return __builtin_bit_cast(unsigned,b);}
#define WAIT_BAR(N) asm volatile("s_waitcnt vmcnt(" #N ") lgkmcnt(0)\n\ts_barrier":::"memory")

__device__ __forceinline__ void qkt(f32x16&p0,f32x16&p1,const char*Kslot,const bf16x8*qr,int r32,int hi){ const f32x16 negm=f32x16{};
  const char*kb=Kslot+hi*1024+r32*16;
  #pragma unroll
  for(int d0=0;d0<4;++d0){
    const bf16x8 b0=*reinterpret_cast<const bf16x8*>(kb+d0*2048);
    const bf16x8 b1=*reinterpret_cast<const bf16x8*>(kb+d0*2048+512);
    if(d0==0){p0=__builtin_amdgcn_mfma_f32_32x32x16_bf16(b0,qr[0],negm,0,0,0);p1=__builtin_amdgcn_mfma_f32_32x32x16_bf16(b1,qr[0],negm,0,0,0);}
    else{p0=__builtin_amdgcn_mfma_f32_32x32x16_bf16(b0,qr[d0],p0,0,0,0);p1=__builtin_amdgcn_mfma_f32_32x32x16_bf16(b1,qr[d0],p1,0,0,0);}}
}
typedef __attribute__((address_space(3))) const char* lds_cptr;
typedef short v4i16_t __attribute__((ext_vector_type(4)));
__device__ __forceinline__ void kload8(bf16x8*kf,lds_cptr kp){
  kf[0]=*(const __attribute__((address_space(3))) bf16x8*)(kp);      kf[1]=*(const __attribute__((address_space(3))) bf16x8*)(kp+512);
  kf[2]=*(const __attribute__((address_space(3))) bf16x8*)(kp+2048); kf[3]=*(const __attribute__((address_space(3))) bf16x8*)(kp+2560);
  kf[4]=*(const __attribute__((address_space(3))) bf16x8*)(kp+4096); kf[5]=*(const __attribute__((address_space(3))) bf16x8*)(kp+4608);
  kf[6]=*(const __attribute__((address_space(3))) bf16x8*)(kp+6144); kf[7]=*(const __attribute__((address_space(3))) bf16x8*)(kp+6656);
}
__device__ __forceinline__ void kload2(bf16x8*kf,lds_cptr kp,int j){ kf[2*j]=*(const __attribute__((address_space(3))) bf16x8*)(kp+j*2048); kf[2*j+1]=*(const __attribute__((address_space(3))) bf16x8*)(kp+j*2048+512); }
__device__ __forceinline__ s16x4 vtr(lds_cptr p){ return __builtin_bit_cast(s16x4,__builtin_amdgcn_ds_read_tr16_b64_v4i16((__attribute__((address_space(3))) v4i16_t*)p)); }
__device__ __forceinline__ float rowmax(const f32x16&p0,const f32x16&p1){
  float a=max3f(p0[0],p0[1],p1[0]),b=max3f(p0[2],p0[3],p1[1]);a=max3f(a,p1[2],p1[3]);
  #pragma unroll
  for(int r=4;r<16;r+=4){a=max3f(a,p0[r],p0[r+1]);b=max3f(b,p0[r+2],p0[r+3]);a=max3f(a,p1[r],p1[r+1]);b=max3f(b,p1[r+2],p1[r+3]);}
  const float m=max2f(a,b);
  auto rr=__builtin_amdgcn_permlane32_swap(__float_as_uint(m),__float_as_uint(m),false,false);
  return max2f(__uint_as_float(rr[0]),__uint_as_float(rr[1]));
}
__device__ __forceinline__ void pv(f32x16*o,int vb,bf16x8 pa0,bf16x8 pa1,bf16x8 pa2,bf16x8 pa3){
  #pragma unroll
  for(int d0=0;d0<2;++d0){s16x4 lo[4],hi[4];
    #pragma unroll
    for(int ks=0;ks<4;++ks){
      asm volatile("ds_read_b64_tr_b16 %0,%1 offset:%c2":"=&v"(lo[ks]):"v"(vb),"i"(d0*4096+ks*1024):"memory");
      asm volatile("ds_read_b64_tr_b16 %0,%1 offset:%c2":"=&v"(hi[ks]):"v"(vb),"i"(d0*4096+ks*1024+512):"memory");}
    asm volatile("s_waitcnt lgkmcnt(0)":::"memory");SBAR();
    #define PK(k) (bf16x8){lo[k][0],lo[k][1],lo[k][2],lo[k][3],hi[k][0],hi[k][1],hi[k][2],hi[k][3]}
    o[d0]=__builtin_amdgcn_mfma_f32_32x32x16_bf16(pa0,PK(0),o[d0],0,0,0);
    o[d0]=__builtin_amdgcn_mfma_f32_32x32x16_bf16(pa1,PK(1),o[d0],0,0,0);
    o[d0]=__builtin_amdgcn_mfma_f32_32x32x16_bf16(pa2,PK(2),o[d0],0,0,0);
    o[d0]=__builtin_amdgcn_mfma_f32_32x32x16_bf16(pa3,PK(3),o[d0],0,0,0);
    #undef PK
  }
}

#ifndef ATTN_STORE16
#define ATTN_STORE16(p,v) (*(u32x4*)(p)=(v))
#endif
template<int THRL> __device__ __forceinline__ void attn_unit(int b,int colQK,int colV,int qb,const bf16*Q,const bf16*__restrict__ K,const bf16*__restrict__ V,bf16*O,char*shm){
  const int tid=tid_fresh(),lane=tid&63,r32=lane&31,hi=lane>>5; const int wid=__builtin_amdgcn_readfirstlane(tid>>6);
  const long rowbase=(long)b*SEQ; const int q0=qb*QB;
  const bf16*Qw=Q+(rowbase+q0+wid*QBLK)*DM+colQK;
  const bf16*Kh=K+rowbase*DM+colQK,*Vh=V+rowbase*DM+colV;
  const unsigned lds0=(unsigned)(uintptr_t)shm;
  float*wsf=(float*)(shm+LDS_WS)+wid*64;
  const bf16*ksrc=Kh+(long)lane*DM+wid*8;
  const bf16*vsrc=Vh+(long)(16*(wid&3)+(lane>>2))*DM+(wid>>2)*32+(lane&3)*8;
  const unsigned kdst=lds0+LDS_K+wid*1024, vdst=lds0+LDS_V+wid*1024;
  #define DMA_K(t,slot) glds16(ksrc+(long)(t)*KVBLK*DM,(unsigned)__builtin_amdgcn_readfirstlane(kdst+(slot)))
  #define DMA_V(t,slot) glds16(vsrc+(long)(t)*KVBLK*DM,(unsigned)__builtin_amdgcn_readfirstlane(vdst+(slot)))
  const int vb0=(int)(lds0+LDS_V)+((lane>>4)&1)*32+(lane&3)*8+(4*hi+((lane&15)>>2))*64;
  const char*Kbase=shm+LDS_K; bf16x8 kf[8];
  const lds_cptr shm3=(lds_cptr)shm; const lds_cptr kp0=shm3+LDS_K+hi*1024+r32*16; const lds_cptr vp0=shm3+LDS_V+((lane>>4)&1)*32+(lane&3)*8+(4*hi+((lane&15)>>2))*64;
  const int NT=(q0+QB)/KVBLK;
  DMA_K(0,0);DMA_V(0,0);DMA_K(1,SLOTB);
  bf16x8 qr[4];
  #pragma unroll
  for(int d0=0;d0<4;++d0)qr[d0]=*reinterpret_cast<const bf16x8*>(&Qw[(long)r32*DM+d0*16+hi*8]);
  float mhat=0.f,l_reg=0.f;f32x16 o[2];o[0]=f32x16{};o[1]=f32x16{};const f32x16 zero16=f32x16{};
  const int qrel=wid*QBLK+r32;
  #define CMASK(P0,P1,t) do{int jb_=(t)-(NT-4); if(jb_>=0)cmask(P0,P1,jb_,qrel,hi);}while(0)
  bool resc=false;
  #define START(P0,P1) do{ const float rm=rowmax(P0,P1); resc=false; \
    { const float dl=rm; mhat=fadd_s(mhat,dl); \
      _Pragma("unroll") for(int r=0;r<16;++r){P0[r]=fsub_s(P0[r],dl);P1[r]=fsub_s(P1[r],dl);} } \
    _Pragma("unroll") for(int r=0;r<16;++r)P0[r]=__builtin_amdgcn_exp2f(P0[r]); }while(0)
  #define RESC() do{ if(resc){ asm volatile("s_waitcnt lgkmcnt(0)":::"memory"); \
      _Pragma("unroll") for(int d_=0;d_<2;++d_) _Pragma("unroll") for(int r=0;r<16;++r)o[d_][r]*=wsf[crow(r,hi)]; } }while(0)
  f32x16 pA0,pA1,pB0,pB1;
  int sl_prev=0,sl_cur=0,sl_next=SLOTB;
  #define ROT() do{sl_prev=sl_cur;sl_cur=sl_next;sl_next=(sl_next==(NSLOT-1)*SLOTB)?0:sl_next+SLOTB;}while(0)
  DMA_K(2,2*SLOTB);
  WAIT_BAR(3);
  qkt(pA0,pA1,Kbase,qr,r32,hi);asm volatile("s_nop 15\n\ts_nop 7":"+v"(pA0),"+v"(pA1));CMASK(pA0,pA1,0);
  START(pA0,pA1);
  _Pragma("unroll") for(int r=0;r<16;++r)pA1[r]=__builtin_amdgcn_exp2f(pA1[r]);
  WAIT_BAR(0);
  DMA_K(3,0);DMA_V(1,SLOTB);
  ROT();
  kload8(kf,kp0+sl_cur);
  WAIT_BAR(2);
  s16x4 vlo[8],vhi[8]; u32x4 pw0,pw1,pw2,pw3;
  #define PKW(P,B) cvtpk_s(P[B],P[B+1])
  #define PAF(k) __builtin_bit_cast(bf16x8,pw##k)
  #define VFR(i) (bf16x8){vlo[i][0],vlo[i][1],vlo[i][2],vlo[i][3],vhi[i][0],vhi[i][1],vhi[i][2],vhi[i][3]}
  #define PIN(x) asm volatile("":"+v"(x))
  #define MX3(a,b,c) __builtin_fmaxf(__builtin_fmaxf((a),(b)),(c))
  #define GAPA(MF,A0,A1,A2,A3,W0,W1,PW) do{ MF; sacc+=A0; sacc+=A1; sacc+=A2; sacc+=A3; PIN(sacc); W0; W1; PIN(PW); SBAR(); }while(0)
  #define EX(v) __builtin_amdgcn_exp2f((v)-mhat)
  #define GAPB(MF,X,B) do{ MF; X[B]=EX(X[B]); X[B+1]=EX(X[B+1]); X[B+2]=EX(X[B+2]); X[B+3]=EX(X[B+3]); PIN(X); SBAR(); }while(0)
  #define VRD(i) do{ vlo[i]=vtr(vp_+(((i)>>2)*4096+((i)&3)*1024)); vhi[i]=vtr(vp_+(((i)>>2)*4096+((i)&3)*1024+512)); }while(0)
  #define KRD(G,j) do{ if(G){ kload2(kf,kp0+sl_next,j); SBAR(); } }while(0)
  #define STEP(C0,C1,P0,P1,t,GK,GV,GL) do{ SBAR(); \
    const lds_cptr vp_=vp0+sl_prev; \
    VRD(0); SBAR(); float sacc=(P0[0]+P0[1]); \
    GAPA(C0=__builtin_amdgcn_mfma_f32_32x32x16_bf16(kf[0],qr[0],zero16,0,0,0), P0[2],P0[3],P0[4],P0[5],     pw0[0]=PKW(P0,0), pw0[1]=PKW(P0,2), pw0); \
    VRD(4); SBAR(); GAPA(C1=__builtin_amdgcn_mfma_f32_32x32x16_bf16(kf[1],qr[0],zero16,0,0,0), P0[6],P0[7],P0[8],P0[9],     pw0[2]=PKW(P0,4), pw0[3]=PKW(P0,6), pw0); \
    VRD(1); SBAR(); GAPA(C0=__builtin_amdgcn_mfma_f32_32x32x16_bf16(kf[2],qr[1],C0,0,0,0),   P0[10],P0[11],P0[12],P0[13], pw1[0]=PKW(P0,8), pw1[1]=PKW(P0,10), pw1); \
    VRD(5); SBAR(); GAPA(C1=__builtin_amdgcn_mfma_f32_32x32x16_bf16(kf[3],qr[1],C1,0,0,0),   P0[14],P0[15],P1[0],P1[1],   pw1[2]=PKW(P0,12),pw1[3]=PKW(P0,14), pw1); \
    VRD(2); SBAR(); GAPA(C0=__builtin_amdgcn_mfma_f32_32x32x16_bf16(kf[4],qr[2],C0,0,0,0),   P1[2],P1[3],P1[4],P1[5],     pw2[0]=PKW(P1,0), pw2[1]=PKW(P1,2), pw2); \
    VRD(6); SBAR(); GAPA(C1=__builtin_amdgcn_mfma_f32_32x32x16_bf16(kf[5],qr[2],C1,0,0,0),   P1[6],P1[7],P1[8],P1[9],     pw2[2]=PKW(P1,4), pw2[3]=PKW(P1,6), pw2); \
    VRD(3); SBAR(); GAPA(C0=__builtin_amdgcn_mfma_f32_32x32x16_bf16(kf[6],qr[3],C0,0,0,0),   P1[10],P1[11],P1[12],P1[13], pw3[0]=PKW(P1,8), pw3[1]=PKW(P1,10), pw3); \
    VRD(7); SBAR(); GAPA(C1=__builtin_amdgcn_mfma_f32_32x32x16_bf16(kf[7],qr[3],C1,0,0,0),   P1[14],P1[15],0.f,0.f,       pw3[2]=PKW(P1,12),pw3[3]=PKW(P1,14), pw3); \
    l_reg+=sacc; \
    if(GK){DMA_K((t)+3,sl_cur);} if(GV){DMA_V((t)+1,sl_next);} \
    CMASK(C0,C1,t); \
    { float a=MX3(C0[0],C0[1],C1[0]),b=MX3(C0[2],C0[3],C1[1]); a=MX3(a,C1[2],C1[3]); \
      _Pragma("unroll") for(int r=4;r<16;r+=4){a=MX3(a,C0[r],C0[r+1]);b=MX3(b,C0[r+2],C0[r+3]);a=MX3(a,C1[r],C1[r+1]);b=MX3(b,C1[r+2],C1[r+3]);} \
      float rm=__builtin_fmaxf(a,b); { auto rr=__builtin_amdgcn_permlane32_swap(__float_as_uint(rm),__float_as_uint(rm),false,false); rm=__builtin_fmaxf(__uint_as_float(rr[0]),__uint_as_float(rr[1])); } \
      resc=false; \
      rm-=mhat; \
      if(__builtin_expect(__any(rm>(float)THRL),0)){ const float dl=__builtin_fmaxf(rm,0.f); mhat+=dl; \
        const float f=__builtin_amdgcn_exp2f(-dl); l_reg*=f; if(hi==0)wsf[r32]=f; resc=true; } } \
    SBAR(); \
    GAPB(o[0]=__builtin_amdgcn_mfma_f32_32x32x16_bf16(PAF(0),VFR(0),o[0],0,0,0), C0,0); \
    GAPB(o[1]=__builtin_amdgcn_mfma_f32_32x32x16_bf16(PAF(0),VFR(4),o[1],0,0,0), C0,4); \
    KRD(GL,0); GAPB(o[0]=__builtin_amdgcn_mfma_f32_32x32x16_bf16(PAF(1),VFR(1),o[0],0,0,0), C0,8); \
    KRD(GL,1); GAPB(o[1]=__builtin_amdgcn_mfma_f32_32x32x16_bf16(PAF(1),VFR(5),o[1],0,0,0), C0,12); \
    KRD(GL,2); GAPB(o[0]=__builtin_amdgcn_mfma_f32_32x32x16_bf16(PAF(2),VFR(2),o[0],0,0,0), C1,0); \
    KRD(GL,3); GAPB(o[1]=__builtin_amdgcn_mfma_f32_32x32x16_bf16(PAF(2),VFR(6),o[1],0,0,0), C1,4); \
    GAPB(o[0]=__builtin_amdgcn_mfma_f32_32x32x16_bf16(PAF(3),VFR(3),o[0],0,0,0), C1,8); \
    GAPB(o[1]=__builtin_amdgcn_mfma_f32_32x32x16_bf16(PAF(3),VFR(7),o[1],0,0,0), C1,12); \
    }while(0)
  int t=1;
  #undef CMASK
  #define CMASK(P0,P1,t) do{}while(0)
  for(;t+5<NT;t+=2){
    STEP(pB0,pB1,pA0,pA1,t,true,true,true);     WAIT_BAR(2); RESC(); ROT();
    STEP(pA0,pA1,pB0,pB1,t+1,true,true,true);   WAIT_BAR(2); RESC(); ROT();
  }
  #undef CMASK
  #define CMASK(P0,P1,t) do{int jb_=(t)-(NT-4); if(jb_>=0)cmask(P0,P1,jb_,qrel,hi);}while(0)
  #define ENDW(tt) do{ if((tt)+3<NT){WAIT_BAR(2);} else if((tt)+2<NT){WAIT_BAR(1);} else {WAIT_BAR(0);} }while(0)
  for(;t+1<NT;t+=2){
    STEP(pB0,pB1,pA0,pA1,t,(t+3<NT),(t+1<NT),(t+1<NT));       ENDW(t);   RESC(); ROT();
    STEP(pA0,pA1,pB0,pB1,t+1,(t+4<NT),(t+2<NT),(t+2<NT));     ENDW(t+1); RESC(); ROT();
  }
  STEP(pB0,pB1,pA0,pA1,NT-1,false,false,false); RESC();
  { float sacc=pB0[0]+pB0[1]; _Pragma("unroll") for(int r=2;r<16;++r)sacc+=pB0[r]; _Pragma("unroll") for(int r=0;r<16;++r)sacc+=pB1[r]; l_reg+=sacc;
    pw0=(u32x4){PKW(pB0,0),PKW(pB0,2),PKW(pB0,4),PKW(pB0,6)};pw1=(u32x4){PKW(pB0,8),PKW(pB0,10),PKW(pB0,12),PKW(pB0,14)};pw2=(u32x4){PKW(pB1,0),PKW(pB1,2),PKW(pB1,4),PKW(pB1,6)};pw3=(u32x4){PKW(pB1,8),PKW(pB1,10),PKW(pB1,12),PKW(pB1,14)};
    SBAR(); pv(o,vb0+sl_cur,PAF(0),PAF(1),PAF(2),PAF(3)); }
  #undef PKW
  #undef PAF
  #undef VFR
  #undef PIN
  #undef MX3
  #undef GAPA
  #undef GAPB
  #undef EX
  #undef VRD
  #undef KRD
  #undef STEP
  #undef ENDW
  {auto rr=__builtin_amdgcn_permlane32_swap(__float_as_uint(l_reg),__float_as_uint(l_reg),false,false);l_reg=__uint_as_float(rr[0])+__uint_as_float(rr[1]);}
  if(hi==0)wsf[32+r32]=l_reg;asm volatile("s_waitcnt lgkmcnt(0)":::"memory");
  float rli[16];
  #pragma unroll
  for(int r=0;r<16;++r)rli[r]=__builtin_amdgcn_rcpf(wsf[32+crow(r,hi)]);
  bf16*Ow=O+(rowbase+q0+wid*QBLK)*DM+colV;
  { bf16*stg=(bf16*)(shm+LDS_OST)+wid*2048;
    #pragma unroll
    for(int r=0;r<16;++r){const int orow=crow(r,hi);
      #pragma unroll
      for(int d0=0;d0<2;++d0)stg[orow*64+d0*32+r32]=__float2bfloat16(o[d0][r]*rli[r]);}
    asm volatile("s_waitcnt lgkmcnt(0)":::"memory");
    #pragma unroll
    for(int i=0;i<4;++i){const int row=i*8+(lane>>3),ch=lane&7; const u32x4 v=*(const u32x4*)(stg+row*64+ch*8); ATTN_STORE16(Ow+(long)row*DM+ch*8,v);} }
  asm volatile("s_waitcnt lgkmcnt(0)\n\ts_barrier":::"memory");
  #undef DMA_K
  #undef DMA_V
  #undef CMASK
  #undef START
  #undef RESC
  #undef ROT
}
constexpr int ATTN_LDS_BYTES=LDS_BYTES;
#undef SBAR
#undef WAIT_BAR
}
constexpr int NWAVES = 8;
constexpr size_t MiB = 1u << 20;
constexpr size_t WS_CTL = 0, CTL_ZERO_BYTES = 1 * MiB;
constexpr size_t WS_SSQA = 1 * MiB, WS_SSQB = 2 * MiB;
constexpr size_t WS_SSQV = 3 * MiB;
constexpr size_t WS_SSQC = 4 * MiB + 512 * 1024;
constexpr size_t WS_ROPE = 5 * MiB;
constexpr size_t WS_WMIX = 9 * MiB, WS_W1 = 27 * MiB, WS_W2 = 35 * MiB;
constexpr size_t WS_XB = 43 * MiB;
constexpr size_t WS_ACT = 75 * MiB, WS_END = 267 * MiB;
constexpr int CW_BAR = 4096;
constexpr int RING_OFF = 0, RING_BYTES = 131072;
constexpr int LDSCTL_OFF = RING_BYTES, MISC_OFF = LDSCTL_OFF + 320;
constexpr int LDS_BYTES = 147456;
#define GAS __attribute__((address_space(1)))
#define LAS __attribute__((address_space(3)))
typedef unsigned short bf16;
typedef unsigned v4u __attribute__((ext_vector_type(4)));
typedef float f32x4 __attribute__((ext_vector_type(4)));
typedef short bf16x8 __attribute__((ext_vector_type(8)));
typedef GAS unsigned gu32;
typedef GAS unsigned long long gu64;
#define RLX_AGENT __ATOMIC_RELAXED, __HIP_MEMORY_SCOPE_AGENT
#define LDS_WAIT() asm volatile("s_waitcnt lgkmcnt(0)" ::: "memory")
#define VM_WAIT() asm volatile("s_waitcnt vmcnt(0)" ::: "memory")
__device__ __forceinline__ unsigned long long rt() { return __builtin_amdgcn_s_memrealtime(); }
__device__ __forceinline__ unsigned f2bf(float f) { unsigned u = __builtin_bit_cast(unsigned, f); return (u + 0x7fffu + ((u >> 16) & 1u)) >> 16; }
__device__ __forceinline__ unsigned pk2(float lo, float hi) { return f2bf(lo) | (f2bf(hi) << 16); }

#define XB_TMO      128
#define XB_XCNT(j)  (256  + 64 * (j))
#define XB_XSUB(j)  (1280 + 64 * (j))
#define XB_XGEN(j)  (2304 + 64 * (j))
#define XB_TOP      3328
#define XB_TOPGEN   3392
#define XCD_BAR_WORDS 3456
#define XB_SPIN_CAP (1u << 18)

__device__ __forceinline__ unsigned xb_ld(unsigned* p)              { return __hip_atomic_load(p, __ATOMIC_RELAXED, __HIP_MEMORY_SCOPE_AGENT); }
__device__ __forceinline__ unsigned xb_add(unsigned* p, unsigned v) { return __hip_atomic_fetch_add(p, v, __ATOMIC_RELAXED, __HIP_MEMORY_SCOPE_AGENT); }
__device__ __forceinline__ unsigned xb_xcc_id() { return (unsigned)__builtin_amdgcn_s_getreg((3 << 11) | 20) & 0xFu; }
#define XB_SPIN(cond, bar) do { unsigned _sp = 0; while (cond) { __builtin_amdgcn_s_sleep(1); \
    if ((++_sp & 255u) == 0u) { if (xb_ld(&(bar)[XB_TMO])) break; if (_sp > XB_SPIN_CAP) { atomicAdd(&(bar)[XB_TMO], 1u); break; } } } } while (0)

struct XcdBarrier {
    unsigned* bar; unsigned x;
    volatile LAS unsigned* st;
};

__device__ __forceinline__ XcdBarrier xcd_barrier_post(unsigned* bar, volatile LAS unsigned* st) {
    XcdBarrier b; b.bar = bar; b.x = xb_xcc_id(); b.st = st;
    if (threadIdx.x == 0) (void)xb_add(&bar[XB_XCNT(b.x)], 1u);
    return b;
}
__device__ __forceinline__ void xcd_barrier_complete(unsigned* bar, unsigned x, unsigned& nloc, unsigned& nx) {
    const unsigned G = gridDim.x * gridDim.y * gridDim.z;
    unsigned sum, cnt, mine, sp = 0u;
    for (;;) {
        sum = 0u; cnt = 0u; mine = 0u;
#pragma unroll
        for (unsigned j = 0; j < 16; ++j) { const unsigned c = xb_ld(&bar[XB_XCNT(j)]); sum += c; cnt += (c > 0u) ? 1u : 0u; mine = (j == x) ? c : mine; }
        if (sum == G) break;
        __builtin_amdgcn_s_sleep(1);
        if ((++sp & 255u) == 0u) { if (xb_ld(&bar[XB_TMO])) break; if (sp > XB_SPIN_CAP) { atomicAdd(&bar[XB_TMO], 1u); break; } }
    }
    nloc = mine > 0u ? mine : 1u; nx = cnt > 0u ? cnt : 1u;
}

__device__ __forceinline__ void xcd_barrier(const XcdBarrier& b) {
    asm volatile("s_waitcnt vmcnt(0)" ::: "memory");
    __syncthreads();
    if (threadIdx.x == 0) {
        unsigned* bar = b.bar;
        __builtin_amdgcn_s_waitcnt(0);
        unsigned nloc = b.st[0], nx = b.st[1];
        if (nloc == 0u) { xcd_barrier_complete(bar, b.x, nloc, nx); b.st[0] = nloc; b.st[1] = nx; }
        const unsigned old = xb_add(&bar[XB_XSUB(b.x)], 1u);
        const unsigned gen = old / nloc;
        if (old + 1u == (gen + 1u) * nloc) {
            __builtin_amdgcn_fence(__ATOMIC_RELEASE, "agent");
            asm volatile("s_waitcnt vmcnt(0)" ::: "memory");
            const unsigned og = xb_add(&bar[XB_TOP], 1u);
            const unsigned tg = og / nx;
            if (og + 1u == (tg + 1u) * nx) xb_add(&bar[XB_TOPGEN], 1u);
            else XB_SPIN(xb_ld(&bar[XB_TOPGEN]) == tg, bar);
            __builtin_amdgcn_fence(__ATOMIC_ACQUIRE, "agent");
            xb_add(&bar[XB_XGEN(b.x)], 1u);
            asm volatile("s_waitcnt vmcnt(0)" ::: "memory");
        } else {
            XB_SPIN(xb_ld(&bar[XB_XGEN(b.x)]) == gen, bar);
            __builtin_amdgcn_fence(__ATOMIC_ACQUIRE, "agent");
            asm volatile("s_waitcnt vmcnt(0)" ::: "memory");
        }
    }
    __syncthreads();
}
struct Args { const void* in[29]; float* out; unsigned char* ws; int ph_lo, ph_hi; };
struct Frame {
    LAS unsigned char* lds;
    volatile LAS unsigned* MISC;
    int tid, lane, wave, vcu, G;
};
typedef float f32x2v __attribute__((ext_vector_type(2)));
__device__ __forceinline__ float wave_sum(float v) {
#pragma unroll
    for (int o = 1; o < 64; o <<= 1) v += __shfl_xor(v, o);
    return v;
}
__device__ __forceinline__ void sincos_rev(double t, float& s, float& c) {
    t -= rint(t);
    const double k = rint(t * 4.0); const float f = (float)(t - k * 0.25), p = f * 6.2831853071795865f, p2 = p * p;
    const float sp = p * (1.0f + p2 * (-1.6666667163e-1f + p2 * (8.3333337680e-3f + p2 * (-1.9841270114e-4f + p2 * 2.7557314297e-6f))));
    const float cp = 1.0f + p2 * (-0.5f + p2 * (4.1666667908e-2f + p2 * (-1.3888889225e-3f + p2 * (2.4801587642e-5f + p2 * -2.7557314297e-7f))));
    const int q = ((int)k) & 3;
    s = (q == 0) ? sp : (q == 1) ? cp : (q == 2) ? -sp : -cp;
    c = (q == 0) ? cp : (q == 1) ? -sp : (q == 2) ? -cp : sp;
}
struct ConvJob { const float* W; int K, N; bf16* WT; const float* sv; int smask; float mul; int perm; };
__device__ __forceinline__ void transpose_item(const ConvJob& J, LAS float* scr, int item, int lane) {
    const int nblk = J.N / 32, kb = item / nblk, nb = item % nblk, k0 = 64 * kb, n0 = 32 * nb;
#pragma unroll 8
    for (int i = 0; i < 32; ++i) { const int kk = 2 * i + (lane >> 5); float sc = J.mul; if (J.sv) sc *= J.sv[(k0 + kk) & J.smask];
        scr[kk * 33 + (lane & 31)] = J.W[(size_t)(k0 + kk) * J.N + n0 + (lane & 31)] * sc; }
    LDS_WAIT(); asm volatile("" ::: "memory");
    const int c = lane & 7;
#pragma unroll
    for (int j = 0; j < 4; ++j) { const int n = (lane >> 3) + 8 * j; const LAS float* s = scr + (8 * c) * 33 + n;
        v4u o; o.x = pk2(s[0 * 33], s[1 * 33]); o.y = pk2(s[2 * 33], s[3 * 33]); o.z = pk2(s[4 * 33], s[5 * 33]); o.w = pk2(s[6 * 33], s[7 * 33]);
        int nn = n0 + n; if (J.perm) { const int r = nn & 255; nn = (nn & ~255) + ((r >> 5) & 1) * 128 + (r >> 6) * 32 + (r & 31); }
        *(GAS v4u*)(J.WT + (size_t)nn * J.K + k0 + 8 * c) = o; }
    LDS_WAIT(); asm volatile("" ::: "memory");
}
__device__ __forceinline__ int conv_items(const ConvJob& J) { return (J.K / 64) * (J.N / 32); }
__device__ __forceinline__ void conv_run(Frame& F, const ConvJob& J0, const ConvJob& J1, const ConvJob& J2, const ConvJob& J3, const ConvJob& J4, int njobs) {
    LAS float* scr = (LAS float*)(F.lds + RING_OFF + F.wave * 16384);
    const int gw = F.vcu * NWAVES + F.wave, NGW = F.G * NWAVES;
    const int c0 = conv_items(J0), c1 = conv_items(J1), c2 = conv_items(J2), c3 = conv_items(J3), c4 = njobs > 4 ? conv_items(J4) : 0;
    const int total = c0 + c1 + c2 + c3 + c4;
    for (int it = gw; it < total; it += NGW) {
        int r = it;
        if (r < c0) { transpose_item(J0, scr, r, F.lane); continue; } r -= c0;
        if (r < c1) { transpose_item(J1, scr, r, F.lane); continue; } r -= c1;
        if (r < c2) { transpose_item(J2, scr, r, F.lane); continue; } r -= c2;
        if (r < c3) { transpose_item(J3, scr, r, F.lane); continue; } r -= c3;
        transpose_item(J4, scr, r, F.lane);
    }
}
__constant__ float INVF_TAB[32] = {1.000000000e+00f, 7.498942093e-01f, 5.623413252e-01f, 4.216965034e-01f, 3.162277660e-01f, 2.371373706e-01f, 1.778279410e-01f, 1.333521432e-01f, 1.000000000e-01f, 7.498942093e-02f, 5.623413252e-02f, 4.216965034e-02f, 3.162277660e-02f, 2.371373706e-02f, 1.778279410e-02f, 1.333521432e-02f, 1.000000000e-02f, 7.498942093e-03f, 5.623413252e-03f, 4.216965034e-03f, 3.162277660e-03f, 2.371373706e-03f, 1.778279410e-03f, 1.333521432e-03f, 1.000000000e-03f, 7.498942093e-04f, 5.623413252e-04f, 4.216965034e-04f, 3.162277660e-04f, 2.371373706e-04f, 1.778279410e-04f, 1.333521432e-04f};
__device__ __forceinline__ void init_phase(Frame& F, const float* x, const int* pos, bf16* XB, float* ssq0, float* rope) {
    const int gw = F.vcu * NWAVES + F.wave, NGW = F.G * NWAVES;
    for (int m = gw; m < T_; m += NGW) {
        const GAS f32x4* xr = (const GAS f32x4*)(x + (size_t)m * 1024) + F.lane; GAS unsigned long long* o8 = (GAS unsigned long long*)(XB + (size_t)m * 1024) + F.lane;
        float s = 0.f;
#pragma unroll
        for (int j = 0; j < 4; ++j) { const f32x4 v = xr[64 * j]; s += (v.x * v.x + v.y * v.y) + (v.z * v.z + v.w * v.w);
            o8[64 * j] = (unsigned long long)pk2(v.x, v.y) | ((unsigned long long)pk2(v.z, v.w) << 32); }
        s = wave_sum(s); if (F.lane == 0) ssq0[m] = s;
    }
    const int gt = (F.vcu * NWAVES + F.wave) * 64 + F.lane, NGT = F.G * NWAVES * 64;
    for (int e = gt; e < T_ * 32; e += NGT) { const int row = e >> 5, i = e & 31;
        const float ang = (float)pos[row] * INVF_TAB[i]; float sn, cs; sincos_rev((double)ang * 0.15915494309189533577, sn, cs);
        *(f32x2v*)(rope + (size_t)e * 2) = (f32x2v){cs, sn}; }
}
__device__ __forceinline__ void compact_phase(Frame& F, const float* slab, float* compact) {
    const int gt = (F.vcu * NWAVES + F.wave) * 64 + F.lane, NGT = F.G * NWAVES * 64;
    for (int r = gt; r < T_; r += NGT) compact[r] = pg8::slab16_sum(slab, r);
}
struct AttnU { int b, cq, cv, qb, o2; };
struct AttnOrder { int vcu, G;
    __device__ __forceinline__ bool next(int idx, AttnU& u) const { const int n = vcu + G * (idx >> 3); if (n >= 256) return false; const int i = idx & 7, h = (n >> 3) & 7, s = n & 7, c = i >> 2, e2 = (i >> 1) & 1;
        u.b = n >> 6; u.cq = (2 * h + c) * 64; u.cv = h * 128 + e2 * 64; u.qb = (i & 1) ? 15 - s : s; u.o2 = c; return true; } };
__device__ __forceinline__ void attn_phase(Frame& F, unsigned char* ldsg, const bf16* Q, const bf16* K, const bf16* V, bf16* O1, bf16* O2, const float* lam4, float lam_init) {
    { AttnU u; AttnOrder S{F.vcu, F.G};
      for (int idx = 0; S.next(idx, u); ++idx) attn_body::attn_unit<8>(u.b, u.cq, u.cv, u.qb, (const attn_body::bf16*)Q, (const attn_body::bf16*)K, (const attn_body::bf16*)V, (attn_body::bf16*)(u.o2 ? O2 : O1), (char*)ldsg); }
    VM_WAIT(); __syncthreads();
    const float la_ = wave_sum(lam4[F.lane] * lam4[64 + F.lane]), lb_ = wave_sum(lam4[128 + F.lane] * lam4[192 + F.lane]);
    const float lam = __expf(la_) - __expf(lb_) + lam_init;
    for (int n = F.vcu; n < 256; n += F.G) {
        const int b = n >> 6, h = (n >> 3) & 7, s = n & 7;
        for (int it = F.tid >> 4; it < 512; it += 32) { const int qb = (it >> 8) ? 15 - s : s; const size_t off = ((size_t)b * SEQ + qb * 256 + (it & 255)) * 1024 + h * 128 + 8 * (F.tid & 15);
            const v4u w1 = *(const v4u*)(O1 + off), w2 = *(const v4u*)(O2 + off); float d[8]; float ss = 0.f;
#pragma unroll
            for (int e = 0; e < 8; ++e) { const unsigned x1 = w1[e >> 1], x2 = w2[e >> 1];
                const float f1 = (e & 1) ? __uint_as_float(x1 & 0xffff0000u) : __uint_as_float(x1 << 16), f2 = (e & 1) ? __uint_as_float(x2 & 0xffff0000u) : __uint_as_float(x2 << 16);
                d[e] = f1 - lam * f2; ss += d[e] * d[e]; }
            ss += __shfl_xor(ss, 1); ss += __shfl_xor(ss, 2); ss += __shfl_xor(ss, 4); ss += __shfl_xor(ss, 8);
            const float r = __builtin_amdgcn_rsqf(ss * (1.0f / 128.0f) + 1e-6f);
            v4u o; o.x = pk2(d[0] * r, d[1] * r); o.y = pk2(d[2] * r, d[3] * r); o.z = pk2(d[4] * r, d[5] * r); o.w = pk2(d[6] * r, d[7] * r);
            *(v4u*)(O1 + off) = o; }
    }
}
__device__ __forceinline__ void ssm_phase(Frame& F, const bf16* U, bf16* GA, const float* a_re, const float* a_im, const float* b_re, const float* b_im, const float* c_re, const float* c_im, const float* dsk, const float* log_dt) {
    const int lane = F.lane, w = F.wave;
    LAS unsigned short* ublk = (LAS unsigned short*)(F.lds + w * 1024);
    LAS float* sblk = (LAS float*)(F.lds + 8192 + w * 8448);
    LAS float* endS = (LAS float*)(F.lds + 8192 + 8 * 8448);
    for (int item = F.vcu; item < 256; item += F.G) {
        const int b = item >> 6, g = item & 63, p = lane;
        const float are = fminf(a_re[g * 64 + p], -1e-4f), aim = a_im[g * 64 + p];
        float lbr, lbi, zr, zi;
        { const float dt = __expf(log_dt[g]), er = __expf(are * dt); float sn, cs; sincos_rev((double)aim * (double)dt * 0.15915494309189533577, sn, cs);
          lbr = er * cs; lbi = er * sn;
          const float nr = lbr - 1.0f, ni = lbi, den = are * are + aim * aim;
          zr = (nr * are + ni * aim) / den; zi = (ni * are - nr * aim) / den; }
        float Bre[16], Bim[16];
#pragma unroll
        for (int q4 = 0; q4 < 4; ++q4) { const f32x4 br = *(const f32x4*)(b_re + (size_t)(g * 64 + p) * 16 + 4 * q4), bi = *(const f32x4*)(b_im + (size_t)(g * 64 + p) * 16 + 4 * q4);
#pragma unroll
            for (int e = 0; e < 4; ++e) { Bre[4 * q4 + e] = zr * br[e] - zi * bi[e]; Bim[4 * q4 + e] = zr * bi[e] + zi * br[e]; } }
        float Bc[32];
#pragma unroll
        for (int kk = 0; kk < 32; ++kk) { const int k = 4 * kk + (lane >> 4), hh = lane & 15; Bc[kk] = (kk < 16) ? c_re[(size_t)(g * 16 + hh) * 64 + k] : -c_im[(size_t)(g * 16 + hh) * 64 + k - 64]; }
        const float dskh = dsk[g * 16 + (lane & 15)];
        const size_t rowbase = (size_t)b * SEQ + (size_t)w * 512;
        float sr = 0.f, si = 0.f;
#define SSM_LOADU(blk) do { const v4u v_ = *(const v4u*)(U + (rowbase + (blk) * 32 + (lane >> 1)) * 1024 + g * 16 + (lane & 1) * 8); LDS_WAIT(); asm volatile("" ::: "memory"); \
        *(LAS v4u*)(ublk + (lane >> 1) * 16 + (lane & 1) * 8) = v_; LDS_WAIT(); asm volatile("" ::: "memory"); } while (0)
#define SSM_STEP(tl) do { const v4u ua_ = *(const LAS v4u*)(ublk + (tl) * 16), ub_ = *(const LAS v4u*)(ublk + (tl) * 16 + 8); float bur_ = 0.f, bui_ = 0.f; \
        _Pragma("unroll") for (int hh_ = 0; hh_ < 16; ++hh_) { const unsigned wd_ = (hh_ < 8) ? ua_[hh_ >> 1] : ub_[(hh_ - 8) >> 1]; \
            const float uh_ = (hh_ & 1) ? __uint_as_float(wd_ & 0xffff0000u) : __uint_as_float(wd_ << 16); bur_ += Bre[hh_] * uh_; bui_ += Bim[hh_] * uh_; } \
        const float nsr_ = lbr * sr - lbi * si + bur_, nsi_ = lbr * si + lbi * sr + bui_; sr = nsr_; si = nsi_; } while (0)
        for (int blk = 0; blk < 16; ++blk) { SSM_LOADU(blk);
#pragma unroll 4
            for (int tl = 0; tl < 32; ++tl) SSM_STEP(tl); }
        endS[w * 128 + p] = sr; endS[w * 128 + 64 + p] = si;
        __syncthreads();
        float pr = lbr, pi = lbi;
#pragma unroll
        for (int q = 0; q < 9; ++q) { const float a = pr * pr - pi * pi, b2 = 2.f * pr * pi; pr = a; pi = b2; }
        sr = 0.f; si = 0.f;
        for (int w2 = 0; w2 < w; ++w2) { const float er_ = endS[w2 * 128 + p], ei_ = endS[w2 * 128 + 64 + p]; const float a = pr * sr - pi * si + er_, b2 = pr * si + pi * sr + ei_; sr = a; si = b2; }
        for (int blk = 0; blk < 16; ++blk) { SSM_LOADU(blk);
            for (int sub = 0; sub < 2; ++sub) {
#pragma unroll 4
                for (int tt = 0; tt < 16; ++tt) { const int tl = sub * 16 + tt; SSM_STEP(tl); sblk[tt * 132 + p] = sr; sblk[tt * 132 + 64 + p] = si; }
                LDS_WAIT(); asm volatile("" ::: "memory");
                f32x4 acc = (f32x4){0.f, 0.f, 0.f, 0.f};
#pragma unroll
                for (int kk = 0; kk < 32; ++kk) { const float av = sblk[(lane & 15) * 132 + 4 * kk + (lane >> 4)]; acc = __builtin_amdgcn_mfma_f32_16x16x4f32(av, Bc[kk], acc, 0, 0, 0); }
#pragma unroll
                for (int r = 0; r < 4; ++r) { const int tl = sub * 16 + 4 * (lane >> 4) + r; const float uv = pg8::bf2f(ublk[tl * 16 + (lane & 15)]);
                    const float y = acc[r] + dskh * uv; GA[(rowbase + blk * 32 + tl) * 1024 + g * 16 + (lane & 15)] = (bf16)f2bf(pg8::gelu_tanh(y)); }
                LDS_WAIT(); asm volatile("" ::: "memory");
            } }
#undef SSM_LOADU
#undef SSM_STEP
        __syncthreads();
    }
}
__device__ __forceinline__ void gate_phase(Frame& F, bf16* ZU, const bf16* ZVT, const float* ssqv, const float* Ws, const float* bs, const float* vg) {
    LAS unsigned short* Al = (LAS unsigned short*)F.lds;
    const int lane = F.lane;
    for (int n = F.vcu; n < 1024; n += F.G) {
        const int b = n >> 8, ch = (n >> 3) & 31, h = n & 7; const int tok0 = b * SEQ + ch * 128;
        { const int s = F.tid & 127; const f32x4* sp = (const f32x4*)(ssqv + (size_t)(tok0 + s) * 24); float sv = 0.f;
#pragma unroll
          for (int q = 0; q < 6; ++q) { const f32x4 a = sp[q]; sv += (a[0] + a[1]) + (a[2] + a[3]); }
          const float rv = __builtin_amdgcn_rsqf(sv * (1.0f / 3072.0f) + 1e-6f);
          for (int t = F.tid >> 7; t < 128; t += 4) { const float wv = (s <= t) ? Ws[(size_t)(h * 128 + t) * 128 + s] * rv : 0.f; Al[t * 136 + s] = (unsigned short)f2bf(wv); } }
        __syncthreads();
        const int dw = h * 384 + 48 * F.wave;
        bf16x8 Bf[3][4];
#pragma unroll
        for (int db = 0; db < 3; ++db)
#pragma unroll
            for (int ks = 0; ks < 4; ++ks) Bf[db][ks] = *(const bf16x8*)(ZVT + (size_t)(dw + 16 * db + (lane & 15)) * T_ + tok0 + 32 * ks + 8 * (lane >> 4));
#pragma unroll
        for (int tb = 0; tb < 8; ++tb) {
            f32x4 acc[3];
#pragma unroll
            for (int db = 0; db < 3; ++db) acc[db] = (f32x4){0.f, 0.f, 0.f, 0.f};
#pragma unroll
            for (int ks = 0; ks < 4; ++ks) if (ks <= tb / 2) {
                const bf16x8 Af = *(const LAS bf16x8*)(Al + (16 * tb + (lane & 15)) * 136 + 32 * ks + 8 * (lane >> 4));
#pragma unroll
                for (int db = 0; db < 3; ++db) acc[db] = __builtin_amdgcn_mfma_f32_16x16x32_bf16(Bf[db][ks], Af, acc[db], 0, 0, 0); }
            const int t = 16 * tb + (lane & 15); const float bsv = bs[h * 128 + t];
#pragma unroll
            for (int db = 0; db < 3; ++db) { const int dcol = dw + 16 * db + 4 * (lane >> 4); const f32x4 gv = *(const f32x4*)(vg + dcol);
                unsigned long long* up = (unsigned long long*)(ZU + (size_t)(tok0 + t) * GH + dcol); const unsigned long long uu = *up;
                const float u0 = __uint_as_float((unsigned)uu << 16), u1 = __uint_as_float((unsigned)uu & 0xffff0000u), u2 = __uint_as_float((unsigned)(uu >> 32) << 16), u3 = __uint_as_float((unsigned)(uu >> 32) & 0xffff0000u);
                const float o0 = u0 * (acc[db][0] * gv[0] + bsv), o1 = u1 * (acc[db][1] * gv[1] + bsv), o2 = u2 * (acc[db][2] * gv[2] + bsv), o3 = u3 * (acc[db][3] * gv[3] + bsv);
                *up = (unsigned long long)pk2(o0, o1) | ((unsigned long long)pk2(o2, o3) << 32); }
        }
        __syncthreads();
    }
}
__device__ __forceinline__ bool step_exists(int st) { return !((st % 7) == 3 && ((st / 7) % 3) != 1); }
typedef const __attribute__((address_space(4))) char* kargp_t;
__device__ __forceinline__ kargp_t kargs() { kargp_t kp = (kargp_t)__builtin_amdgcn_kernarg_segment_ptr(); asm volatile("" : "+s"(kp)); return kp; }
#define ARGP(i) (*(const void* const __attribute__((address_space(4)))*)(kp + 8 * (i)))
#define ARGI(off) (*(const int __attribute__((address_space(4)))*)(kp + (off)))
__device__ __forceinline__ void run_step(const int st, unsigned char* lds) {
    kargp_t kp = kargs();
    Frame F;
    F.lds = (LAS unsigned char*)lds; F.MISC = (volatile LAS unsigned*)(F.lds + MISC_OFF);
    F.tid = tid_fresh(); F.G = gridDim.x; int bx = blockIdx.x;
    asm volatile("" : "+s"(F.G), "+s"(bx));
    F.lane = F.tid & 63; F.wave = __builtin_amdgcn_readfirstlane(F.tid >> 6);
    F.vcu = (F.G % 8 == 0) ? (bx % 8) * (F.G / 8) + bx / 8 : bx;
    unsigned char* ws = (unsigned char*)ARGP(30);
    bf16* WMIX = (bf16*)(ws + WS_WMIX); bf16* XB = (bf16*)(ws + WS_XB);
    unsigned char* act = ws + WS_ACT;
    const int layer = st / 7, slot = st % 7, kind = layer % 3, j = layer / 3;
    float* ssq_in = (float*)(ws + WS_SSQC);
    float* ssq_mid = (float*)(ws + WS_SSQB);
    float* ssq_out = (float*)(ws + WS_SSQA);
    float* ssqv = (float*)(ws + WS_SSQV);
    const float lam_init = (layer == 0) ? 0.2f : 0.55605820415f;
    if (slot == 0) {
        const float* norm_mix = (const float*)ARGP(2); const float* norm_mlp = (const float*)ARGP(3);
        ConvJob J0{}, J1{}, J2{}, J3{}, J4{}; int nj = 4;
        if (kind == 0) {
            J0 = ConvJob{(const float*)ARGP(6) + (size_t)j * 1024 * 3072, 1024, 3072, WMIX, norm_mix + layer * 1024, 1023, 1.f, 1};
            J1 = ConvJob{(const float*)ARGP(11) + (size_t)j * 1024 * 1024, 1024, 1024, WMIX + 3 * MiB, (const float*)ARGP(10) + j * 128, 127, 1.f - lam_init, 0};
        } else if (kind == 1) {
            J0 = ConvJob{(const float*)ARGP(12) + (size_t)j * 1024 * 1024, 1024, 1024, WMIX, norm_mix + layer * 1024, 1023, 1.f, 0};
            J1 = ConvJob{(const float*)ARGP(21) + (size_t)j * 1024 * 1024, 1024, 1024, WMIX + 1 * MiB, nullptr, 0, 1.f, 0};
            J4 = ConvJob{(const float*)ARGP(23) + (size_t)j * 1024 * 1024, 1024, 1024, WMIX + 2 * MiB, nullptr, 0, 1.f, 0}; nj = 5;
        } else {
            J0 = ConvJob{(const float*)ARGP(24) + (size_t)j * 1024 * 6144, 1024, 6144, WMIX, norm_mix + layer * 1024, 1023, 1.f, 0};
            J1 = ConvJob{(const float*)ARGP(28) + (size_t)j * 3072 * 1024, 3072, 1024, WMIX + 6 * MiB, nullptr, 0, 1.f, 0};
        }
        J2 = ConvJob{(const float*)ARGP(4) + (size_t)layer * 1024 * 4096, 1024, 4096, (bf16*)(ws + WS_W1), norm_mlp + layer * 1024, 1023, 1.f, 0};
        J3 = ConvJob{(const float*)ARGP(5) + (size_t)layer * 4096 * 1024, 4096, 1024, (bf16*)(ws + WS_W2), nullptr, 0, 1.f, 0};
        conv_run(F, J0, J1, J2, J3, J4, nj);
        if (layer == 0) init_phase(F, (const float*)ARGP(0), (const int*)ARGP(1), XB, ssq_in, (float*)(ws + WS_ROPE));
        else compact_phase(F, ssq_out, ssq_in);
    } else if (slot == 1) {
        if (kind == 0) {
            pg8::Gemm g{XB, WMIX, T_, 3072, 1024}; pg8::StaticOrder S; S.init(T_, 3072, F.G, bx);
            pg8::EpiQKV E{(bf16*)act, (bf16*)(act + 32 * MiB), (bf16*)(act + 64 * MiB), ssq_in, (const float*)ARGP(7) + j * 64, (const float*)ARGP(8) + j * 64, (const float*)(ws + WS_ROPE)};
            pg8::gemm_phase<pg8::EpiQKV, pg8::StaticOrder, true, true>(F.lds + RING_OFF, g, S, E);
        } else if (kind == 1) {
            pg8::Gemm g{XB, WMIX, T_, 1024, 1024}; pg8::StaticOrder S; S.init(T_, 1024, F.G, bx);
            pg8::EpiRowScale<0, false> E{(bf16*)act, 1024, ssq_in};
            pg8::gemm_phase<pg8::EpiRowScale<0, false>, pg8::StaticOrder, true, true>(F.lds + RING_OFF, g, S, E);
        } else {
            { pg8::Gemm g{XB, WMIX, T_, GH, 1024}; pg8::StaticOrder S; S.init(T_, GH, F.G, bx);
              pg8::EpiRowScale<2, false> E{(bf16*)act, GH, ssq_in};
              pg8::gemm_phase<pg8::EpiRowScale<2, false>, pg8::StaticOrder, true, true>(F.lds + RING_OFF, g, S, E); }
            { pg8::Gemm g{WMIX + (size_t)GH * 1024, XB, GH, T_, 1024}; pg8::StaticOrder S; S.init(GH, T_, F.G, bx);
              pg8::EpiGmV E{(bf16*)(act + 96 * MiB), T_, ssq_in, ssqv};
              pg8::gemm_phase<pg8::EpiGmV, pg8::StaticOrder, true, true>(F.lds + RING_OFF, g, S, E); }
        }
    } else if (slot == 2) {
        if (kind == 0) attn_phase(F, lds + RING_OFF, (const bf16*)act, (const bf16*)(act + 32 * MiB), (const bf16*)(act + 64 * MiB), (bf16*)(act + 96 * MiB), (bf16*)(act + 128 * MiB),
                                  (const float*)ARGP(9) + j * 256, lam_init);
        else if (kind == 1) ssm_phase(F, (const bf16*)act, (bf16*)(act + 32 * MiB), (const float*)ARGP(13) + j * 4096, (const float*)ARGP(14) + j * 4096, (const float*)ARGP(15) + (size_t)j * 65536,
                                      (const float*)ARGP(16) + (size_t)j * 65536, (const float*)ARGP(17) + (size_t)j * 65536, (const float*)ARGP(18) + (size_t)j * 65536,
                                      (const float*)ARGP(19) + j * 1024, (const float*)ARGP(20) + j * 64);
        else gate_phase(F, (bf16*)act, (const bf16*)(act + 96 * MiB), ssqv, (const float*)ARGP(26) + (size_t)j * 8 * 128 * 128, (const float*)ARGP(27) + j * 1024, (const float*)ARGP(25) + j * GH);
    } else if (slot == 3) {
        pg8::Gemm g{(const bf16*)(act + 32 * MiB), WMIX + 1 * MiB, T_, 1024, 1024}; pg8::StaticOrder S; S.init(T_, 1024, F.G, bx);
        pg8::EpiGlu E{(bf16*)(act + 64 * MiB), (const bf16*)(act + 32 * MiB), (const float*)ARGP(22) + j * 1024};
        pg8::gemm_phase<pg8::EpiGlu, pg8::StaticOrder, true, true>(F.lds + RING_OFF, g, S, E);
    } else if (slot == 4 || slot == 6) {
        float* out = (float*)ARGP(29);
        const bf16* A; const bf16* Bt; int K; const float* base = (layer == 0 && slot == 4) ? (const float*)ARGP(0) : out; float* sq;
        if (slot == 6) { A = (const bf16*)act; Bt = (const bf16*)(ws + WS_W2); K = 4096; sq = (layer < 3) ? ssq_out : nullptr; }
        else { sq = ssq_mid;
            if (kind == 0) { A = (const bf16*)(act + 96 * MiB); Bt = WMIX + 3 * MiB; K = 1024; }
            else if (kind == 1) { A = (const bf16*)(act + 64 * MiB); Bt = WMIX + 2 * MiB; K = 1024; }
            else { A = (const bf16*)act; Bt = WMIX + 6 * MiB; K = GH; } }
        pg8::Gemm g{A, Bt, T_, 1024, K}; pg8::StaticOrder S; S.init(T_, 1024, F.G, bx);
        pg8::EpiRes E{base, out, XB, sq};
        pg8::gemm_phase<pg8::EpiRes, pg8::StaticOrder, true, true>(F.lds + RING_OFF, g, S, E);
    } else {
        pg8::Gemm g{XB, (const bf16*)(ws + WS_W1), T_, FF, 1024}; pg8::StaticOrder S; S.init(T_, FF, F.G, bx);
        pg8::EpiRowScale<1, true> E{(bf16*)act, FF, ssq_mid};
        pg8::gemm_phase<pg8::EpiRowScale<1, true>, pg8::StaticOrder, true, true>(F.lds + RING_OFF, g, S, E);
    }
}
__global__ void __launch_bounds__(NWAVES * 64, 2) trunk_fwd(Args args) {
    extern __shared__ __attribute__((aligned(16))) unsigned char lds[];
    for (int u = threadIdx.x; u < (LDS_BYTES - LDSCTL_OFF) / 4; u += NWAVES * 64) ((LAS unsigned*)((LAS unsigned char*)lds + LDSCTL_OFF))[u] = 0u;
    __syncthreads();
    if (args.ph_hi - args.ph_lo > 1) (void)xcd_barrier_post((unsigned*)((gu32*)(args.ws + WS_CTL) + CW_BAR), (volatile LAS unsigned*)((LAS unsigned char*)lds + MISC_OFF) + 8);
    int st = args.ph_lo;
    for (;;) {
        { kargp_t kp = kargs(); if (st >= ARGI(252)) break; }
        if (step_exists(st)) {
            run_step(st, lds);
            kargp_t kp = kargs();
            if (st + 1 < ARGI(252)) { XcdBarrier bar; bar.bar = (unsigned*)((gu32*)((unsigned char*)ARGP(30) + WS_CTL) + CW_BAR); bar.x = xb_xcc_id(); bar.st = (volatile LAS unsigned*)((LAS unsigned char*)lds + MISC_OFF) + 8;
                xcd_barrier(bar); }
        }
        ++st;
    }
}

#ifdef DBG_DUMP_OFF
__global__ void dbg_dump(const unsigned short* src, float* out, int n) { for (int i = blockIdx.x * blockDim.x + threadIdx.x; i < n; i += gridDim.x * blockDim.x) out[i] = __uint_as_float((unsigned)src[i] << 16); }
#endif
#ifndef MK_PER_PHASE
#define MK_PER_PHASE 1
#endif
extern "C" void kernel_launch(void* const* d_in, const int* in_sizes, int n_in, void* d_out, int out_size, void* d_ws, size_t ws_size, hipStream_t stream) {
    static int grid = 0;
    static_assert(sizeof(Args) == 256, "Args layout: in[29] at 0, out at 232, ws at 240, ph_lo 248, ph_hi 252");
    if (grid == 0) {
        if (n_in != 29 || in_sizes[0] != T_ * 1024 || out_size != T_ * 1024 || ws_size < WS_END) { fprintf(stderr, "kernel_launch: unexpected shapes / workspace (n_in %d, ws %zu); nothing launched\n", n_in, ws_size); grid = -1; return; }
        int dev = 0, cus = 0;
        if (hipGetDevice(&dev) != hipSuccess || hipDeviceGetAttribute(&cus, hipDeviceAttributeMultiprocessorCount, dev) != hipSuccess) { grid = -1; return; }
        if (hipFuncSetAttribute((const void*)trunk_fwd, hipFuncAttributeMaxDynamicSharedMemorySize, LDS_BYTES) != hipSuccess) { fprintf(stderr, "kernel_launch: hipFuncSetAttribute failed\n"); grid = -1; return; }
        int per_cu = 0; (void)hipOccupancyMaxActiveBlocksPerMultiprocessor(&per_cu, (const void*)trunk_fwd, NWAVES * 64, LDS_BYTES); (void)hipGetLastError();
        if (per_cu < 1) fprintf(stderr, "kernel_launch: occupancy query reports %d blocks per CU\n", per_cu);
        grid = cus;
    }
    if (grid < 0) return;
    (void)hipMemsetAsync((char*)d_ws + WS_CTL, 0, CTL_ZERO_BYTES, stream);
    Args a{};
    for (int i = 0; i < 29; ++i) a.in[i] = d_in[i];
    a.out = (float*)d_out; a.ws = (unsigned char*)d_ws;
#ifndef DBG_LAST_STEP
#define DBG_LAST_STEP 27
#endif
#if MK_PER_PHASE
    for (int st = 0; st <= DBG_LAST_STEP; ++st) { if ((st % 7) == 3 && ((st / 7) % 3) != 1) continue; a.ph_lo = st; a.ph_hi = st + 1;
        hipLaunchKernelGGL(trunk_fwd, dim3(grid), dim3(NWAVES * 64), LDS_BYTES, stream, a); }
#ifdef DBG_DUMP_OFF
    hipLaunchKernelGGL(dbg_dump, dim3(2048), dim3(256), 0, stream, (const unsigned short*)((const char*)d_ws + (size_t)(DBG_DUMP_OFF)), (float*)d_out, T_ * 1024);
#endif
#else
    a.ph_lo = 0; a.ph_hi = 28;
    hipLaunchKernelGGL(trunk_fwd, dim3(grid), dim3(NWAVES * 64), LDS_BYTES, stream, a);
#endif
}
```

```cpp
#include <hip/hip_runtime.h>
#include <hip/hip_bf16.h>
#include <cstdio>
#include <cstdint>
#include <cmath>

constexpr int BATCH = 4, SEQ = 4096, DM_ = 1024, T_ = BATCH * SEQ;
constexpr int FF = 4096, GF = 6144, GH = 3072;
constexpr float EPS_ = 1e-6f;

__device__ __forceinline__ int tid_fresh() { int t = threadIdx.x; asm volatile("" : "+v"(t)); return t; }

namespace pg8 {
#define PG8_LAS __attribute__((address_space(3)))
typedef unsigned short bf16_t;
typedef short bf16x8 __attribute__((ext_vector_type(8)));
typedef float f32x4 __attribute__((ext_vector_type(4)));
typedef unsigned u32x4 __attribute__((ext_vector_type(4)));
constexpr int BM = 256, BK = 64, HALF = 128, HTB = HALF * BK * 2  , STAGE_BYTES = 8 * HTB, NXCD = 8, WGM = 8;

__host__ __device__ __forceinline__ int lds_byte(int r, int c) { const int st = (r >> 4) * 2 + (c >> 5), rr = r & 15, cc = c & 31, ob = rr * 64 + cc * 2; return st * 1024 + (ob ^ (((ob >> 9) & 1) << 5)); }
__host__ __device__ __forceinline__ void stage_rc(int b, int& R, int& C) { const int st = b / 1024, sb = b % 1024, swz = sb ^ (((sb >> 9) & 1) << 5); R = (st >> 1) * 16 + swz / 64; C = (st & 1) * 32 + (swz % 64) / 2; }
__host__ __device__ __forceinline__ int perm32(int rho) { const int n = rho >> 4, i = rho & 15; return 8 * (i >> 2) + 4 * n + (i & 3); }

struct Unit { int pm, pn; };
struct Gemm { const bf16_t* A; const bf16_t* Bt; int M, N, K; };

struct StaticOrder {
    int nM, nN, nwg, G, c;
    __host__ __device__ void init(int M, int N, int G_, int c_) { nM = M / BM; nN = N / BM; nwg = nM * nN; G = G_; c = c_; }
    __host__ __device__ bool next(int i, Unit& u) const {
        const long L = (long)i * G + c; if (L >= nwg) return false;
        int wgid = (int)L; { const int q = nwg / NXCD, r = nwg % NXCD, xcd = wgid % NXCD, off = wgid / NXCD; wgid = (xcd < r ? xcd * (q + 1) : r * (q + 1) + (xcd - r) * q) + off; }
        const int nig = WGM * nN, gid = wgid / nig, fm = gid * WGM, gsz = (nM - fm) < WGM ? (nM - fm) : WGM;
        u.pm = fm + ((wgid % nig) % gsz); u.pn = (wgid % nig) / gsz; return true;
    }
    __device__ __forceinline__ void a_ready(const Unit&) const {}
    __device__ __forceinline__ void done(const Unit&) const {}
};

__device__ __forceinline__ unsigned cvt_pk_bf16(float lo, float hi) { unsigned r; asm volatile("v_cvt_pk_bf16_f32 %0, %1, %2" : "=v"(r) : "v"(lo), "v"(hi)); return r; }
typedef float f32x2 __attribute__((ext_vector_type(2)));
__device__ __forceinline__ float bf2f(unsigned short h) { return __uint_as_float((unsigned)h << 16); }
__device__ __forceinline__ float gelu_tanh(float x) {
    const float z2 = 1.5957691216057308f * (x + 0.044715f * x * x * x);
    return x * __builtin_amdgcn_rcpf(1.0f + __builtin_amdgcn_exp2f(-1.4426950408889634f * z2)); }
__device__ __forceinline__ float sigmoidf_(float a) { return __builtin_amdgcn_rcpf(1.0f + __builtin_amdgcn_exp2f(-1.4426950408889634f * a)); }
__device__ __forceinline__ float rs_of(float ssq) { return __builtin_amdgcn_rsqf(ssq * (1.0f / 1024.0f) + 1e-6f); }
__device__ __forceinline__ float slab16_sum(const float* slab, int row) { const f32x4* p = (const f32x4*)(slab + (size_t)row * 16); const f32x4 a = p[0], b = p[1], c = p[2], d = p[3];
    return (((a[0] + a[1]) + (a[2] + a[3])) + ((b[0] + b[1]) + (b[2] + b[3]))) + (((c[0] + c[1]) + (c[2] + c[3])) + ((d[0] + d[1]) + (d[2] + d[3]))); }
#ifndef EPI_WT
#define EPI_WT 0
#endif
__device__ __forceinline__ void st16(void* p, const u32x4 v) {
#if EPI_WT
    asm volatile("global_store_dwordx4 %0, %1, off sc1\n\ts_nop 1" :: "v"(p), "v"(v) : "memory");
#else
    *(u32x4*)p = v;
#endif
}
__device__ __forceinline__ u32x4 pack8(const f32x4 v0, const f32x4 v1) { u32x4 w; w.x = cvt_pk_bf16(v0[0], v0[1]); w.y = cvt_pk_bf16(v0[2], v0[3]); w.z = cvt_pk_bf16(v1[0], v1[1]); w.w = cvt_pk_bf16(v1[2], v1[3]); return w; }

template <int ACT> struct EpiRowScale {
    static constexpr bool PERM = true, AFTER_DRAIN = false;
    bf16_t* O; int ldc; const PG8_LAS float* rsl; int dbg;
    __device__ __forceinline__ void operator()(const f32x4 (&acc)[2][2][4][2], const Unit& u, int wr, int wc, int fr, int fq) const {
        const int row0 = u.pm * BM + wr * 64 + fr, col0 = u.pn * BM + wc * 32 + 8 * fq;
#ifdef DBG_EPI_NOMATH
        if (dbg) { _Pragma("unroll") for (int ai = 0; ai < 2; ++ai) _Pragma("unroll") for (int bj = 0; bj < 2; ++bj) _Pragma("unroll") for (int m = 0; m < 4; ++m) _Pragma("unroll") for (int n = 0; n < 2; ++n) asm volatile("" :: "v"(acc[ai][bj][m][n])); return; }
#endif
#pragma unroll
        for (int ai = 0; ai < 2; ++ai)
#pragma unroll
            for (int m = 0; m < 4; ++m) { const int row = row0 + ai * HALF + m * 16; const float rsr = rsl[ai * HALF + wr * 64 + m * 16 + fr]; bf16_t* rowp = O + (size_t)row * ldc + col0;
#pragma unroll
                for (int bj = 0; bj < 2; ++bj) { f32x4 v0 = acc[ai][bj][m][0] * rsr, v1 = acc[ai][bj][m][1] * rsr;
#pragma unroll
                    for (int e = 0; e < 4; ++e) {
                        if (ACT == 1) { const float a = fmaxf(v0[e], 0.f), b = fmaxf(v1[e], 0.f); v0[e] = a * a; v1[e] = b * b; }
                        if (ACT == 2) { v0[e] = gelu_tanh(v0[e]); v1[e] = gelu_tanh(v1[e]); } }
                    const u32x4 pk_ = pack8(v0, v1);
#ifdef DBG_EPI_NOSTORE
                    if (dbg) { asm volatile("" :: "v"(pk_)); } else
#endif
                    st16(rowp + bj * HALF, pk_); } }
    }
};
struct EpiGmV {
    static constexpr bool PERM = true, AFTER_DRAIN = false;
    bf16_t* O; int ldc; const float* ssq; float* ssqv;
    __device__ __forceinline__ void operator()(const f32x4 (&acc)[2][2][4][2], const Unit& u, int wr, int wc, int fr, int fq) const {
        const int row0 = u.pm * BM + wr * 64 + fr, col0 = u.pn * BM + wc * 32 + 8 * fq;
        float rsv[2][8], part[2][8];
#pragma unroll
        for (int bj = 0; bj < 2; ++bj) { const f32x4 s0 = *(const f32x4*)(ssq + col0 + bj * HALF), s1 = *(const f32x4*)(ssq + col0 + bj * HALF + 4);
#pragma unroll
            for (int e = 0; e < 4; ++e) { rsv[bj][e] = rs_of(s0[e]); rsv[bj][4 + e] = rs_of(s1[e]); part[bj][e] = 0.f; part[bj][4 + e] = 0.f; } }
#pragma unroll
        for (int ai = 0; ai < 2; ++ai)
#pragma unroll
            for (int m = 0; m < 4; ++m) { const int row = row0 + ai * HALF + m * 16; bf16_t* rowp = O + (size_t)row * ldc + col0;
#pragma unroll
                for (int bj = 0; bj < 2; ++bj) { f32x4 v0, v1;
#pragma unroll
                    for (int e = 0; e < 4; ++e) { v0[e] = gelu_tanh(acc[ai][bj][m][0][e] * rsv[bj][e]); v1[e] = gelu_tanh(acc[ai][bj][m][1][e] * rsv[bj][4 + e]);
                        part[bj][e] += v0[e] * v0[e]; part[bj][4 + e] += v1[e] * v1[e]; }
                    st16(rowp + bj * HALF, pack8(v0, v1)); } }
#pragma unroll
        for (int bj = 0; bj < 2; ++bj)
#pragma unroll
            for (int e = 0; e < 8; ++e) { float p = part[bj][e]; p += __shfl_xor(p, 1); p += __shfl_xor(p, 2); p += __shfl_xor(p, 4); p += __shfl_xor(p, 8);
                if (fr == 0) ssqv[(size_t)(col0 + bj * HALF + e) * 24 + 2 * u.pm + wr] = p; }
    }
};
struct EpiGlu {
    static constexpr bool PERM = true, AFTER_DRAIN = false;
    bf16_t* O; const bf16_t* G; const float* bias;
    __device__ __forceinline__ void operator()(const f32x4 (&acc)[2][2][4][2], const Unit& u, int wr, int wc, int fr, int fq) const {
        const int row0 = u.pm * BM + wr * 64 + fr, col0 = u.pn * BM + wc * 32 + 8 * fq;
        u32x4 gw[2][4][2]; f32x4 bv[2][2];
#pragma unroll
        for (int ai = 0; ai < 2; ++ai)
#pragma unroll
            for (int m = 0; m < 4; ++m)
#pragma unroll
                for (int bj = 0; bj < 2; ++bj) gw[ai][m][bj] = *(const u32x4*)(G + (size_t)(row0 + ai * HALF + m * 16) * 1024 + col0 + bj * HALF);
#pragma unroll
        for (int bj = 0; bj < 2; ++bj) { bv[bj][0] = *(const f32x4*)(bias + col0 + bj * HALF); bv[bj][1] = *(const f32x4*)(bias + col0 + bj * HALF + 4); }
#pragma unroll
        for (int ai = 0; ai < 2; ++ai)
#pragma unroll
            for (int m = 0; m < 4; ++m) { const size_t off = (size_t)(row0 + ai * HALF + m * 16) * 1024 + col0;
#pragma unroll
                for (int bj = 0; bj < 2; ++bj) { const u32x4 w = gw[ai][m][bj]; f32x4 v0, v1;
#pragma unroll
                    for (int e = 0; e < 4; ++e) { const unsigned w0 = w[e >> 1], w1 = w[2 + (e >> 1)];
                        const float g0 = (e & 1) ? __uint_as_float(w0 & 0xffff0000u) : __uint_as_float(w0 << 16), g1 = (e & 1) ? __uint_as_float(w1 & 0xffff0000u) : __uint_as_float(w1 << 16);
                        v0[e] = g0 * sigmoidf_(acc[ai][bj][m][0][e] + bv[bj][0][e]); v1[e] = g1 * sigmoidf_(acc[ai][bj][m][1][e] + bv[bj][1][e]); }
                    st16(O + off + bj * HALF, pack8(v0, v1)); } }
    }
};
struct EpiRes {
    static constexpr bool PERM = true, AFTER_DRAIN = false;
    float* out; bf16_t* xb; float* ssq;
    __device__ __forceinline__ void operator()(const f32x4 (&acc)[2][2][4][2], const Unit& u, int wr, int wc, int fr, int fq) const {
        const int row0 = u.pm * BM + wr * 64 + fr, col0 = u.pn * BM + wc * 32 + 8 * fq;
        u32x4 bw[2][4][2];
#pragma unroll
        for (int ai = 0; ai < 2; ++ai)
#pragma unroll
            for (int m = 0; m < 4; ++m)
#pragma unroll
                for (int bj = 0; bj < 2; ++bj) bw[ai][m][bj] = *(const u32x4*)(xb + (size_t)(row0 + ai * HALF + m * 16) * 1024 + col0 + bj * HALF);
#pragma unroll
        for (int ai = 0; ai < 2; ++ai)
#pragma unroll
            for (int m = 0; m < 4; ++m) { const int row = row0 + ai * HALF + m * 16; const size_t off = (size_t)row * 1024 + col0; float ss = 0.f;
#pragma unroll
                for (int bj = 0; bj < 2; ++bj) { const u32x4 w = bw[ai][m][bj]; f32x4 o0, o1;
#pragma unroll
                    for (int e = 0; e < 4; ++e) { const unsigned w0 = w[e >> 1], w1 = w[2 + (e >> 1)];
                        o0[e] = ((e & 1) ? __uint_as_float(w0 & 0xffff0000u) : __uint_as_float(w0 << 16)) + acc[ai][bj][m][0][e];
                        o1[e] = ((e & 1) ? __uint_as_float(w1 & 0xffff0000u) : __uint_as_float(w1 << 16)) + acc[ai][bj][m][1][e]; }
                    if (out != nullptr) { *(f32x4*)(out + off + bj * HALF) = o0; *(f32x4*)(out + off + bj * HALF + 4) = o1; }
                    ss += (o0[0] * o0[0] + o0[1] * o0[1]) + (o0[2] * o0[2] + o0[3] * o0[3]) + (o1[0] * o1[0] + o1[1] * o1[1]) + (o1[2] * o1[2] + o1[3] * o1[3]);
                    if (out == nullptr) st16(xb + off + bj * HALF, pack8(o0, o1)); }
                ss += __shfl_xor(ss, 16); ss += __shfl_xor(ss, 32);
                if (ssq != nullptr && fq == 0) ssq[(size_t)row * 16 + 4 * u.pn + wc] = ss; }
    }
};
struct EpiQKV {
    static constexpr bool PERM = true, AFTER_DRAIN = false;
    bf16_t* Q; bf16_t* K; bf16_t* V; const PG8_LAS float* rsl; const PG8_LAS int* posl; const float* qg; const float* kg;
    __device__ __forceinline__ void operator()(const f32x4 (&acc)[2][2][4][2], const Unit& u, int wr, int wc, int fr, int fq) const {
        const int row0 = u.pm * BM + wr * 64 + fr, lrow0 = wr * 64 + fr; const int sect = u.pn >> 2, pnl = u.pn & 3; const int colb = pnl * 256 + wc * 64 + 8 * fq;
        if (sect == 2) {
#pragma unroll
            for (int ai = 0; ai < 2; ++ai)
#pragma unroll
                for (int m = 0; m < 4; ++m) { const int row = row0 + ai * HALF + m * 16; const float rsr = rsl[lrow0 + ai * HALF + m * 16]; bf16_t* rowp = V + (size_t)row * 1024 + colb;
#pragma unroll
                    for (int bj = 0; bj < 2; ++bj) st16(rowp + bj * 32, pack8(acc[ai][bj][m][0] * rsr, acc[ai][bj][m][1] * rsr)); }
        } else {
            const float* gn = sect == 0 ? qg : kg; bf16_t* dst = sect == 0 ? Q : K; const float osc = sect == 0 ? 0.125f * 1.4426950408889634f : 1.0f;
            float g[2][8], ifq[8];
#pragma unroll
            for (int bj = 0; bj < 2; ++bj) { const f32x4 a = *(const f32x4*)(gn + bj * 32 + 8 * fq), b = *(const f32x4*)(gn + bj * 32 + 8 * fq + 4);
#pragma unroll
                for (int e = 0; e < 4; ++e) { g[bj][e] = a[e]; g[bj][4 + e] = b[e]; } }
#pragma unroll
            for (int e = 0; e < 8; ++e) ifq[e] = __builtin_amdgcn_exp2f(-(float)(8 * fq + e) * 0.41524101186092029f);
#pragma unroll
            for (int ai = 0; ai < 2; ++ai)
#pragma unroll
                for (int m = 0; m < 4; ++m) { const int row = row0 + ai * HALF + m * 16, lrow = lrow0 + ai * HALF + m * 16; const float rsr = rsl[lrow]; const float posf = (float)posl[lrow];
                    float x[2][8]; float ss = 0.f;
#pragma unroll
                    for (int bj = 0; bj < 2; ++bj)
#pragma unroll
                        for (int e = 0; e < 8; ++e) { x[bj][e] = acc[ai][bj][m][e >> 2][e & 3] * rsr; ss += x[bj][e] * x[bj][e]; }
                    ss += __shfl_xor(ss, 16); ss += __shfl_xor(ss, 32);
                    const float r = __builtin_amdgcn_rsqf(ss * (1.0f / 64.0f) + 1e-6f) ;
                    f32x4 o1a, o1b, o2a, o2b;
#pragma unroll
                    for (int e = 0; e < 8; ++e) { const float ang = posf * ifq[e]; const float rev = __builtin_amdgcn_fractf(ang * 0.15915494309189533577f);
                        const float co = __builtin_amdgcn_cosf(rev), si = __builtin_amdgcn_sinf(rev);
                        const float x1 = x[0][e] * r * g[0][e], x2 = x[1][e] * r * g[1][e];
                        const float a = (x1 * co - x2 * si) * osc, b = (x2 * co + x1 * si) * osc;
                        if (e < 4) { o1a[e] = a; o2a[e] = b; } else { o1b[e - 4] = a; o2b[e - 4] = b; } }
                    bf16_t* rowp = dst + (size_t)row * 1024 + colb;
                    st16(rowp, pack8(o1a, o1b)); st16(rowp + 32, pack8(o2a, o2b)); }
        }
    }
};

template <class Epi, class Sched, bool ALIGN_EPI = false, bool SP2 = false>
__device__ __forceinline__ void gemm_phase(PG8_LAS unsigned char* lds, const Gemm g, const Sched& S, const Epi& E) {
    const int tid = tid_fresh(), wid = __builtin_amdgcn_readfirstlane(tid >> 6), lane = tid & 63, wr = wid >> 2, wc = wid & 3, fr = lane & 15, fq = lane >> 4;
    const int K = g.K, nt = K / BK;
    unsigned voffA[2], voffB[2];
#pragma unroll
    for (int i = 0; i < 2; ++i) { int R, C; stage_rc(tid * 16 + i * 8192, R, C); const int Rb = Epi::PERM ? ((R & ~31) + perm32(R & 31)) : R;
        voffA[i] = (unsigned)(R * K + C) * 2u; voffB[i] = (unsigned)(Rb * K + C) * 2u; }
    const size_t kstep = (size_t)(BK * 2);
    const size_t hstep = (size_t)HALF * K * 2;
    const size_t tstep = 2 * hstep;
    const unsigned ldsw = (unsigned)wid * 1024u;
    const int aoff = lds_byte(wr * 64 + fr, fq * 8), boff = lds_byte(wc * 32 + fr, fq * 8);
#define PG8_SA(b, h) (((b) * 2 + (h)) * HTB)
#define PG8_SB(b, h) ((4 + (b) * 2 + (h)) * HTB)
#define PG8_STAGE(bufoff, gbase, voff) do { _Pragma("unroll") for (int _i = 0; _i < 2; ++_i) \
        __builtin_amdgcn_global_load_lds((const unsigned*)((const char*)(gbase) + (voff)[_i]), (PG8_LAS unsigned*)(lds + (bufoff) + ldsw + _i * 8192), 16, 0, 0); } while (0)
#define PG8_LDA(dst, b, h) do { _Pragma("unroll") for (int m = 0; m < 4; ++m) _Pragma("unroll") for (int k = 0; k < 2; ++k) dst[m][k] = *(const PG8_LAS bf16x8*)(lds + PG8_SA(b, h) + aoff + m * 2048 + k * 1024); } while (0)
#define PG8_LDB(dst, b, h) do { _Pragma("unroll") for (int n = 0; n < 2; ++n) _Pragma("unroll") for (int k = 0; k < 2; ++k) dst[n][k] = *(const PG8_LAS bf16x8*)(lds + PG8_SB(b, h) + boff + n * 2048 + k * 1024); } while (0)
#define PG8_MMA(ai, bj, At, Bt) do { __builtin_amdgcn_s_setprio(1); _Pragma("unroll") for (int m = 0; m < 4; ++m) _Pragma("unroll") for (int n = 0; n < 2; ++n) _Pragma("unroll") for (int k = 0; k < 2; ++k) \
        acc[ai][bj][m][n] = __builtin_amdgcn_mfma_f32_16x16x32_bf16(Bt[n][k], At[m][k], acc[ai][bj][m][n], 0, 0, 0); __builtin_amdgcn_s_setprio(0); } while (0)
#define PG8_WAIT_V(n) asm volatile("s_waitcnt vmcnt(" #n ")" ::: "memory")
#define PG8_WAIT_L(n) asm volatile("s_waitcnt lgkmcnt(" #n ")" ::: "memory")
#define PG8_BAR __builtin_amdgcn_s_barrier()
#define PG8_SCHED __builtin_amdgcn_sched_barrier(0)
    Unit cur, nxt; int ui = 0;
    if (!S.next(0, cur)) return;
    f32x4 acc[2][2][4][2];
#pragma unroll
    for (int a = 0; a < 2; ++a)
#pragma unroll
        for (int b = 0; b < 2; ++b)
#pragma unroll
            for (int m = 0; m < 4; ++m)
#pragma unroll
                for (int n = 0; n < 2; ++n) acc[a][b][m][n] = (f32x4){0.f, 0.f, 0.f, 0.f};
    bf16x8 At[4][2], B0[2][2], B1[2][2];
    const char* cA = (const char*)g.A + (size_t)cur.pm * tstep; const char* cB = (const char*)g.Bt + (size_t)cur.pn * tstep;
    S.a_ready(cur);
    if constexpr (SP2) {
        PG8_STAGE(PG8_SB(0, 0), cB, voffB); PG8_STAGE(PG8_SB(0, 1), cB + hstep, voffB); PG8_STAGE(PG8_SA(0, 0), cA, voffA); PG8_STAGE(PG8_SA(0, 1), cA + hstep, voffA);
        if (wr == 1) PG8_BAR;
        PG8_WAIT_V(2); PG8_BAR;
        PG8_STAGE(PG8_SB(1, 0), cB + kstep, voffB); PG8_STAGE(PG8_SA(1, 0), cA + kstep, voffA); PG8_STAGE(PG8_SB(1, 1), cB + hstep + kstep, voffB);
        PG8_WAIT_V(6); PG8_BAR;
    } else {
        PG8_STAGE(PG8_SB(0, 0), cB, voffB); PG8_STAGE(PG8_SA(0, 0), cA, voffA); PG8_STAGE(PG8_SB(0, 1), cB + hstep, voffB); PG8_STAGE(PG8_SA(0, 1), cA + hstep, voffA);
        if (wr == 1) PG8_BAR;
        PG8_WAIT_V(4); PG8_BAR;
        PG8_STAGE(PG8_SB(1, 0), cB + kstep, voffB); PG8_STAGE(PG8_SA(1, 0), cA + kstep, voffA); PG8_STAGE(PG8_SB(1, 1), cB + hstep + kstep, voffB);
        PG8_WAIT_V(6); PG8_BAR;
    }
    for (;;) {
        const bool has_next = S.next(ui + 1, nxt);
        const char* nA = has_next ? (const char*)g.A + (size_t)nxt.pm * tstep : cA; const char* nB = has_next ? (const char*)g.Bt + (size_t)nxt.pn * tstep : cB;
        for (int t = 0; t < nt; t += 2) {
            const bool last = (t == nt - 2);
            const char* a1 = cA + (size_t)(t + 1) * kstep;
            const char* a2 = last ? nA : cA + (size_t)(t + 2) * kstep; const char* b2 = last ? nB : cB + (size_t)(t + 2) * kstep;
            const char* a3 = a2 + kstep; const char* b3 = b2 + kstep;
            if (last && has_next) S.a_ready(nxt);
            if constexpr (SP2) {
            PG8_LDB(B0, 0, 0); PG8_LDB(B1, 0, 1); PG8_SCHED; PG8_LDA(At, 0, 0); PG8_STAGE(PG8_SA(1, 1), a1 + hstep, voffA);
            PG8_WAIT_V(8); PG8_WAIT_L(0); PG8_BAR; PG8_MMA(0, 0, At, B0); PG8_MMA(0, 1, At, B1); PG8_BAR; PG8_SCHED;
            PG8_LDA(At, 0, 1); PG8_STAGE(PG8_SB(0, 0), b2, voffB); PG8_STAGE(PG8_SB(0, 1), b2 + hstep, voffB); PG8_STAGE(PG8_SA(0, 0), a2, voffA);
            PG8_WAIT_V(8); PG8_WAIT_L(0); PG8_BAR; PG8_MMA(1, 0, At, B0); PG8_MMA(1, 1, At, B1); PG8_BAR; PG8_SCHED;
            PG8_LDB(B0, 1, 0); PG8_LDB(B1, 1, 1); PG8_SCHED; PG8_LDA(At, 1, 0); PG8_STAGE(PG8_SA(0, 1), a2 + hstep, voffA);
            PG8_WAIT_V(8); PG8_WAIT_L(0); PG8_BAR; PG8_MMA(0, 0, At, B0); PG8_MMA(0, 1, At, B1); PG8_BAR; PG8_SCHED;
            PG8_LDA(At, 1, 1); PG8_STAGE(PG8_SB(1, 0), b3, voffB); PG8_STAGE(PG8_SB(1, 1), b3 + hstep, voffB); PG8_STAGE(PG8_SA(1, 0), a3, voffA);
            PG8_WAIT_V(8); PG8_WAIT_L(0); PG8_BAR; PG8_MMA(1, 0, At, B0); PG8_MMA(1, 1, At, B1); PG8_BAR; PG8_SCHED;
            } else {
            PG8_LDB(B0, 0, 0); PG8_SCHED; PG8_LDA(At, 0, 0); PG8_STAGE(PG8_SA(1, 1), a1 + hstep, voffA);
            PG8_WAIT_L(8); PG8_BAR; PG8_WAIT_L(0); PG8_MMA(0, 0, At, B0); PG8_BAR; PG8_SCHED;
            PG8_LDB(B1, 0, 1); PG8_STAGE(PG8_SB(0, 0), b2, voffB);
            PG8_BAR; PG8_WAIT_L(0); PG8_MMA(0, 1, At, B1); PG8_BAR;
            PG8_LDA(At, 0, 1); PG8_STAGE(PG8_SA(0, 0), a2, voffA);
            PG8_BAR; PG8_WAIT_L(0); PG8_MMA(1, 0, At, B0); PG8_BAR; PG8_SCHED;
            PG8_STAGE(PG8_SB(0, 1), b2 + hstep, voffB);
            PG8_WAIT_V(6); PG8_BAR; PG8_MMA(1, 1, At, B1); PG8_BAR;
            PG8_LDB(B0, 1, 0); PG8_SCHED; PG8_LDA(At, 1, 0); PG8_STAGE(PG8_SA(0, 1), a2 + hstep, voffA);
            PG8_WAIT_L(8); PG8_BAR; PG8_WAIT_L(0); PG8_MMA(0, 0, At, B0); PG8_BAR; PG8_SCHED;
            PG8_LDB(B1, 1, 1); PG8_STAGE(PG8_SB(1, 0), b3, voffB);
            PG8_BAR; PG8_WAIT_L(0); PG8_MMA(0, 1, At, B1); PG8_BAR;
            PG8_LDA(At, 1, 1); PG8_STAGE(PG8_SA(1, 0), a3, voffA);
            PG8_BAR; PG8_WAIT_L(0); PG8_MMA(1, 0, At, B0); PG8_BAR; PG8_SCHED;
            PG8_STAGE(PG8_SB(1, 1), b3 + hstep, voffB);
            PG8_WAIT_V(6); PG8_BAR; PG8_MMA(1, 1, At, B1); PG8_BAR;
            }
        }
        if constexpr (ALIGN_EPI) { if (wr == 0) PG8_BAR; }
        if constexpr (!Epi::AFTER_DRAIN) { E(acc, cur, wr, wc, fr, fq); S.done(cur); }
        if (!has_next) break;
#pragma unroll
        for (int a = 0; a < 2; ++a)
#pragma unroll
            for (int b = 0; b < 2; ++b)
#pragma unroll
                for (int m = 0; m < 4; ++m)
#pragma unroll
                    for (int n = 0; n < 2; ++n) acc[a][b][m][n] = (f32x4){0.f, 0.f, 0.f, 0.f};
        cur = nxt; cA = nA; cB = nB; ++ui;
        if constexpr (ALIGN_EPI) { if (wr == 1) PG8_BAR; }
    }
    PG8_WAIT_V(0);
    if constexpr (!ALIGN_EPI) { if (wr == 0) PG8_BAR; }
    PG8_BAR;
    if constexpr (Epi::AFTER_DRAIN) { E.fused(acc, cur, wr, wc, fr, fq, lds, wid, lane); S.done(cur); }
#undef PG8_SA
#undef PG8_SB
#undef PG8_STAGE
#undef PG8_LDA
#undef PG8_LDB
#undef PG8_MMA
#undef PG8_WAIT_V
#undef PG8_WAIT_L
#undef PG8_BAR
#undef PG8_SCHED
}
}
#ifndef PG8_SP2
#define PG8_SP2 true
#endif
#include <hip/hip_bf16.h>
#include <cmath>
namespace attn_body {
using bf16=__hip_bfloat16;
using bf16x8=__attribute__((ext_vector_type(8)))short;
using s16x4=__attribute__((ext_vector_type(4)))short;
using f32x16=__attribute__((ext_vector_type(16)))float;
using u32x4=__attribute__((ext_vector_type(4)))unsigned;
constexpr int BATCH=4,NHEAD=16,SEQ=4096,D=64,DM=NHEAD*D;
constexpr int NW=8,QBLK=32,QB=QBLK*NW,KVBLK=64,NQB=SEQ/QB;
constexpr int ATTN_PITCH=DM, ATTN_UNIT_ROWS=QB;
__device__ __forceinline__ int crow(int r,int hi){return (r&3)+8*(r>>2)+4*hi;}
#define SBAR() __builtin_amdgcn_sched_barrier(0)
__device__ __forceinline__ void cmask(f32x16&p0,f32x16&p1,int jb,int qrel,int hi){
  const float NEG=-INFINITY; int kb=64*jb+4*hi;
  #pragma unroll
  for(int r=0;r<16;++r){int kv=kb+(r&3)+8*(r>>2); if(kv>qrel)p0[r]=NEG; if(kv+32>qrel)p1[r]=NEG;}
}

constexpr int NSLOT=3, SLOTB=8192;
constexpr int LDS_K=0, LDS_V=NSLOT*SLOTB, LDS_WS=LDS_V+NSLOT*2*SLOTB, LDS_OST=LDS_WS+NW*64*4, LDS_BYTES=LDS_OST+NW*4096;
constexpr float C2=0.125f*1.4426950408889634f;
__device__ __forceinline__ void glds16(const void*gsrc,unsigned lds_dst){unsigned keep;
  asm volatile("s_mov_b32 %0, m0\n\ts_mov_b32 m0, %2\n\ts_nop 0\n\tglobal_load_lds_dwordx4 %1, off\n\ts_mov_b32 m0, %0":"=&s"(keep):"v"(gsrc),"s"(lds_dst):"memory");}
__device__ __forceinline__ float max3f(float a,float b,float c){float r;asm("v_max3_f32 %0, %1, %2, %3":"=v"(r):"v"(a),"v"(b),"v"(c));return r;}
__device__ __forceinline__ float max2f(float a,float b){float r;asm("v_max_f32_e32 %0, %1, %2":"=v"(r):"v"(a),"v"(b));return r;}
__device__ __forceinline__ float fadd_s(float a,float b){float r;asm("v_add_f32_e32 %0, %1, %2":"=v"(r):"v"(a),"v"(b));return r;}
__device__ __forceinline__ float fsub_s(float a,float b){float r;asm("v_sub_f32_e32 %0, %1, %2":"=v"(r):"v"(a),"v"(b));return r;}
typedef float f32x2_t __attribute__((ext_vector_type(2))); typedef __bf16 bf16x2_t __attribute__((ext_vector_type(2)));
__device__ __forceinline__ unsigned cvtpk_s(float lo,float hi){f32x2_t v={lo,hi};bf16x2_t b=__builtin_convertvector(v,bf16x2_t);return __builtin_bit_cast(unsigned,b);}
#define WAIT_BAR(N) asm volatile("s_waitcnt vmcnt(" #N ") lgkmcnt(0)\n\ts_barrier":::"memory")

__device__ __forceinline__ void qkt(f32x16&p0,f32x16&p1,const char*Kslot,const bf16x8*qr,int r32,int hi){ const f32x16 negm=f32x16{};
  const char*kb=Kslot+hi*1024+r32*16;
  #pragma unroll
  for(int d0=0;d0<4;++d0){
    const bf16x8 b0=*reinterpret_cast<const bf16x8*>(kb+d0*2048);
    const bf16x8 b1=*reinterpret_cast<const bf16x8*>(kb+d0*2048+512);
    if(d0==0){p0=__builtin_amdgcn_mfma_f32_32x32x16_bf16(b0,qr[0],negm,0,0,0);p1=__builtin_amdgcn_mfma_f32_32x32x16_bf16(b1,qr[0],negm,0,0,0);}
    else{p0=__builtin_amdgcn_mfma_f32_32x32x16_bf16(b0,qr[d0],p0,0,0,0);p1=__builtin_amdgcn_mfma_f32_32x32x16_bf16(b1,qr[d0],p1,0,0,0);}}
}
typedef __attribute__((address_space(3))) const char* lds_cptr;
typedef short v4i16_t __attribute__((ext_vector_type(4)));
__device__ __forceinline__ void kload8(bf16x8*kf,lds_cptr kp){
  kf[0]=*(const __attribute__((address_space(3))) bf16x8*)(kp);      kf[1]=*(const __attribute__((address_space(3))) bf16x8*)(kp+512);
  kf[2]=*(const __attribute__((address_space(3))) bf16x8*)(kp+2048); kf[3]=*(const __attribute__((address_space(3))) bf16x8*)(kp+2560);
  kf[4]=*(const __attribute__((address_space(3))) bf16x8*)(kp+4096); kf[5]=*(const __attribute__((address_space(3))) bf16x8*)(kp+4608);
  kf[6]=*(const __attribute__((address_space(3))) bf16x8*)(kp+6144); kf[7]=*(const __attribute__((address_space(3))) bf16x8*)(kp+6656);
}
__device__ __forceinline__ void kload2(bf16x8*kf,lds_cptr kp,int j){ kf[2*j]=*(const __attribute__((address_space(3))) bf16x8*)(kp+j*2048); kf[2*j+1]=*(const __attribute__((address_space(3))) bf16x8*)(kp+j*2048+512); }
__device__ __forceinline__ s16x4 vtr(lds_cptr p){ return __builtin_bit_cast(s16x4,__builtin_amdgcn_ds_read_tr16_b64_v4i16((__attribute__((address_space(3))) v4i16_t*)p)); }
__device__ __forceinline__ float rowmax(const f32x16&p0,const f32x16&p1){
  float a=max3f(p0[0],p0[1],p1[0]),b=max3f(p0[2],p0[3],p1[1]);a=max3f(a,p1[2],p1[3]);
  #pragma unroll
  for(int r=4;r<16;r+=4){a=max3f(a,p0[r],p0[r+1]);b=max3f(b,p0[r+2],p0[r+3]);a=max3f(a,p1[r],p1[r+1]);b=max3f(b,p1[r+2],p1[r+3]);}
  const float m=max2f(a,b);
  auto rr=__builtin_amdgcn_permlane32_swap(__float_as_uint(m),__float_as_uint(m),false,false);
  return max2f(__uint_as_float(rr[0]),__uint_as_float(rr[1]));
}
__device__ __forceinline__ void pv(f32x16*o,int vb,bf16x8 pa0,bf16x8 pa1,bf16x8 pa2,bf16x8 pa3){
  #pragma unroll
  for(int d0=0;d0<4;++d0){s16x4 lo[4],hi[4];
    #pragma unroll
    for(int ks=0;ks<4;++ks){
      asm volatile("ds_read_b64_tr_b16 %0,%1 offset:%c2":"=&v"(lo[ks]):"v"(vb),"i"(d0*4096+ks*1024):"memory");
      asm volatile("ds_read_b64_tr_b16 %0,%1 offset:%c2":"=&v"(hi[ks]):"v"(vb),"i"(d0*4096+ks*1024+512):"memory");}
    asm volatile("s_waitcnt lgkmcnt(0)":::"memory");SBAR();
    #define PK(k) (bf16x8){lo[k][0],lo[k][1],lo[k][2],lo[k][3],hi[k][0],hi[k][1],hi[k][2],hi[k][3]}
    o[d0]=__builtin_amdgcn_mfma_f32_32x32x16_bf16(pa0,PK(0),o[d0],0,0,0);
    o[d0]=__builtin_amdgcn_mfma_f32_32x32x16_bf16(pa1,PK(1),o[d0],0,0,0);
    o[d0]=__builtin_amdgcn_mfma_f32_32x32x16_bf16(pa2,PK(2),o[d0],0,0,0);
    o[d0]=__builtin_amdgcn_mfma_f32_32x32x16_bf16(pa3,PK(3),o[d0],0,0,0);
    #undef PK
  }
}

#ifndef ATTN_STORE16
#define ATTN_STORE16(p,v) (*(u32x4*)(p)=(v))
#endif
template<int THRL> __device__ __forceinline__ void attn_unit(int b,int colQK,int colV,int qb,const bf16*Q,const bf16*__restrict__ K,const bf16*__restrict__ V,bf16*O,char*shm,const float sh){
  const int tid=tid_fresh(),lane=tid&63,r32=lane&31,hi=lane>>5; const int wid=__builtin_amdgcn_readfirstlane(tid>>6);
  const long rowbase=(long)b*SEQ; const int q0=qb*QB;
  const bf16*Qw=Q+(rowbase+q0+wid*QBLK)*DM+colQK;
  const bf16*Kh=K+rowbase*DM+colQK,*Vh=V+rowbase*DM+colV;
  const unsigned lds0=(unsigned)(uintptr_t)shm;
  float*wsf=(float*)(shm+LDS_WS)+wid*64;
  const bf16*ksrc=Kh+(long)lane*DM+wid*8;
  const bf16*vsrc=Vh+(long)(16*(wid&3)+(lane>>2))*DM+(wid>>2)*32+(lane&3)*8;
  const unsigned kdst=lds0+LDS_K+wid*1024, vdst=lds0+LDS_V+wid*1024;
  #define DMA_K(t,slot) glds16(ksrc+(long)(t)*KVBLK*DM,(unsigned)__builtin_amdgcn_readfirstlane(kdst+(slot)))
  #define DMA_V(t,slot) do{ glds16(vsrc+(long)(t)*KVBLK*DM,(unsigned)__builtin_amdgcn_readfirstlane(vdst+2*(slot))); glds16(vsrc+(long)(t)*KVBLK*DM+64,(unsigned)__builtin_amdgcn_readfirstlane(vdst+2*(slot)+8192)); }while(0)
  const int vb0=(int)(lds0+LDS_V)+((lane>>4)&1)*32+(lane&3)*8+(4*hi+((lane&15)>>2))*64;
  const char*Kbase=shm+LDS_K; bf16x8 kf[8];
  const lds_cptr shm3=(lds_cptr)shm; const lds_cptr kp0=shm3+LDS_K+hi*1024+r32*16; const lds_cptr vp0=shm3+LDS_V+((lane>>4)&1)*32+(lane&3)*8+(4*hi+((lane&15)>>2))*64;
  const int NT=(q0+QB)/KVBLK;
  DMA_K(0,0);DMA_V(0,0);DMA_K(1,SLOTB);
  bf16x8 qr[4];
  #pragma unroll
  for(int d0=0;d0<4;++d0)qr[d0]=*reinterpret_cast<const bf16x8*>(&Qw[(long)r32*DM+d0*16+hi*8]);
  float l_reg=0.f;f32x16 o[4];o[0]=f32x16{};o[1]=f32x16{};o[2]=f32x16{};o[3]=f32x16{};const f32x16 zero16=f32x16{};
  const int qrel=wid*QBLK+r32;
  #define CMASK(P0,P1,t) do{int jb_=(t)-(NT-4); if(jb_>=0)cmask(P0,P1,jb_,qrel,hi);}while(0)
  const bool shon=__builtin_amdgcn_readfirstlane(sh>0.f?1:0)!=0;
  #define START(P0,P1) do{ if(shon){ _Pragma("unroll") for(int r=0;r<16;++r){P0[r]=fsub_s(P0[r],sh);P1[r]=fsub_s(P1[r],sh);} } \
    _Pragma("unroll") for(int r=0;r<16;++r)P0[r]=__builtin_amdgcn_exp2f(P0[r]); }while(0)
  #define RESC() do{}while(0)
  f32x16 pA0,pA1,pB0,pB1;
  int sl_prev=0,sl_cur=0,sl_next=SLOTB;
  #define ROT() do{sl_prev=sl_cur;sl_cur=sl_next;sl_next=(sl_next==(NSLOT-1)*SLOTB)?0:sl_next+SLOTB;}while(0)
  DMA_K(2,2*SLOTB);
  WAIT_BAR(4);
  qkt(pA0,pA1,Kbase,qr,r32,hi);asm volatile("s_nop 15\n\ts_nop 7":"+v"(pA0),"+v"(pA1));CMASK(pA0,pA1,0);
  START(pA0,pA1);
  _Pragma("unroll") for(int r=0;r<16;++r)pA1[r]=__builtin_amdgcn_exp2f(pA1[r]);
  WAIT_BAR(0);
  DMA_K(3,0);DMA_V(1,SLOTB);
  ROT();
  kload8(kf,kp0+sl_cur);
  WAIT_BAR(3);
  s16x4 vlo[8],vhi[8]; u32x4 pw0,pw1,pw2,pw3;
  #define PKW(P,B) cvtpk_s(P[B],P[B+1])
  #define PAF(k) __builtin_bit_cast(bf16x8,pw##k)
  #define VFR(i) (bf16x8){vlo[i][0],vlo[i][1],vlo[i][2],vlo[i][3],vhi[i][0],vhi[i][1],vhi[i][2],vhi[i][3]}
  #define PIN(x) asm volatile("":"+v"(x))
  #define MX3(a,b,c) __builtin_fmaxf(__builtin_fmaxf((a),(b)),(c))
  #define GAPA(MF,A0,A1,A2,A3,W0,W1,PW) do{ MF; sacc+=A0; sacc+=A1; sacc+=A2; sacc+=A3; PIN(sacc); W0; W1; PIN(PW); SBAR(); }while(0)
  #define EX(v) __builtin_amdgcn_exp2f(v)
  #define GAPB(MF,X,B) do{ MF; X[B]=EX(X[B]); X[B+1]=EX(X[B+1]); PIN(X); SBAR(); }while(0)
  #define VRD(i) do{ vlo[i]=vtr(vp_+(((i)>>2)*4096+((i)&3)*1024)); vhi[i]=vtr(vp_+(((i)>>2)*4096+((i)&3)*1024+512)); }while(0)
  #define VRD2(i) do{ vlo[i]=vtr(vp_+(8192+((i)>>2)*4096+((i)&3)*1024)); vhi[i]=vtr(vp_+(8192+((i)>>2)*4096+((i)&3)*1024+512)); SBAR(); }while(0)
  #define KRD(G,j) do{ if(G){ kload2(kf,kp0+sl_next,j); SBAR(); } }while(0)
  #define STEP(C0,C1,P0,P1,t,GK,GV,GL) do{ SBAR(); \
    const lds_cptr vp_=vp0+2*sl_prev; \
    VRD(0); SBAR(); float sacc=(P0[0]+P0[1]); \
    GAPA(C0=__builtin_amdgcn_mfma_f32_32x32x16_bf16(kf[0],qr[0],zero16,0,0,0), P0[2],P0[3],P0[4],P0[5],     pw0[0]=PKW(P0,0), pw0[1]=PKW(P0,2), pw0); \
    VRD(4); SBAR(); GAPA(C1=__builtin_amdgcn_mfma_f32_32x32x16_bf16(kf[1],qr[0],zero16,0,0,0), P0[6],P0[7],P0[8],P0[9],     pw0[2]=PKW(P0,4), pw0[3]=PKW(P0,6), pw0); \
    VRD(1); SBAR(); GAPA(C0=__builtin_amdgcn_mfma_f32_32x32x16_bf16(kf[2],qr[1],C0,0,0,0),   P0[10],P0[11],P0[12],P0[13], pw1[0]=PKW(P0,8), pw1[1]=PKW(P0,10), pw1); \
    VRD(5); SBAR(); GAPA(C1=__builtin_amdgcn_mfma_f32_32x32x16_bf16(kf[3],qr[1],C1,0,0,0),   P0[14],P0[15],P1[0],P1[1],   pw1[2]=PKW(P0,12),pw1[3]=PKW(P0,14), pw1); \
    VRD(2); SBAR(); GAPA(C0=__builtin_amdgcn_mfma_f32_32x32x16_bf16(kf[4],qr[2],C0,0,0,0),   P1[2],P1[3],P1[4],P1[5],     pw2[0]=PKW(P1,0), pw2[1]=PKW(P1,2), pw2); \
    VRD(6); SBAR(); GAPA(C1=__builtin_amdgcn_mfma_f32_32x32x16_bf16(kf[5],qr[2],C1,0,0,0),   P1[6],P1[7],P1[8],P1[9],     pw2[2]=PKW(P1,4), pw2[3]=PKW(P1,6), pw2); \
    VRD(3); SBAR(); GAPA(C0=__builtin_amdgcn_mfma_f32_32x32x16_bf16(kf[6],qr[3],C0,0,0,0),   P1[10],P1[11],P1[12],P1[13], pw3[0]=PKW(P1,8), pw3[1]=PKW(P1,10), pw3); \
    VRD(7); SBAR(); GAPA(C1=__builtin_amdgcn_mfma_f32_32x32x16_bf16(kf[7],qr[3],C1,0,0,0),   P1[14],P1[15],0.f,0.f,       pw3[2]=PKW(P1,12),pw3[3]=PKW(P1,14), pw3); \
    l_reg+=sacc; \
    if(GK){DMA_K((t)+3,sl_cur);} if(GV){DMA_V((t)+1,sl_next);} \
    CMASK(C0,C1,t); \
    if(shon){ _Pragma("unroll") for(int r=0;r<16;++r){C0[r]-=sh;C1[r]-=sh;} } \
    SBAR(); \
    GAPB(o[0]=__builtin_amdgcn_mfma_f32_32x32x16_bf16(PAF(0),VFR(0),o[0],0,0,0), C0,0);  VRD2(0); \
    GAPB(o[1]=__builtin_amdgcn_mfma_f32_32x32x16_bf16(PAF(0),VFR(4),o[1],0,0,0), C0,2);  VRD2(4); \
    KRD(GL,0); GAPB(o[0]=__builtin_amdgcn_mfma_f32_32x32x16_bf16(PAF(1),VFR(1),o[0],0,0,0), C0,4);  VRD2(1); \
    KRD(GL,1); GAPB(o[1]=__builtin_amdgcn_mfma_f32_32x32x16_bf16(PAF(1),VFR(5),o[1],0,0,0), C0,6);  VRD2(5); \
    KRD(GL,2); GAPB(o[0]=__builtin_amdgcn_mfma_f32_32x32x16_bf16(PAF(2),VFR(2),o[0],0,0,0), C0,8);  VRD2(2); \
    KRD(GL,3); GAPB(o[1]=__builtin_amdgcn_mfma_f32_32x32x16_bf16(PAF(2),VFR(6),o[1],0,0,0), C0,10); VRD2(6); \
    GAPB(o[0]=__builtin_amdgcn_mfma_f32_32x32x16_bf16(PAF(3),VFR(3),o[0],0,0,0), C0,12); VRD2(3); \
    GAPB(o[1]=__builtin_amdgcn_mfma_f32_32x32x16_bf16(PAF(3),VFR(7),o[1],0,0,0), C0,14); VRD2(7); \
    GAPB(o[2]=__builtin_amdgcn_mfma_f32_32x32x16_bf16(PAF(0),VFR(0),o[2],0,0,0), C1,0); \
    GAPB(o[3]=__builtin_amdgcn_mfma_f32_32x32x16_bf16(PAF(0),VFR(4),o[3],0,0,0), C1,2); \
    GAPB(o[2]=__builtin_amdgcn_mfma_f32_32x32x16_bf16(PAF(1),VFR(1),o[2],0,0,0), C1,4); \
    GAPB(o[3]=__builtin_amdgcn_mfma_f32_32x32x16_bf16(PAF(1),VFR(5),o[3],0,0,0), C1,6); \
    GAPB(o[2]=__builtin_amdgcn_mfma_f32_32x32x16_bf16(PAF(2),VFR(2),o[2],0,0,0), C1,8); \
    GAPB(o[3]=__builtin_amdgcn_mfma_f32_32x32x16_bf16(PAF(2),VFR(6),o[3],0,0,0), C1,10); \
    GAPB(o[2]=__builtin_amdgcn_mfma_f32_32x32x16_bf16(PAF(3),VFR(3),o[2],0,0,0), C1,12); \
    GAPB(o[3]=__builtin_amdgcn_mfma_f32_32x32x16_bf16(PAF(3),VFR(7),o[3],0,0,0), C1,14); \
    }while(0)
  int t=1;
  #undef CMASK
  #define CMASK(P0,P1,t) do{}while(0)
  for(;t+5<NT;t+=2){
    STEP(pB0,pB1,pA0,pA1,t,true,true,true);     WAIT_BAR(3); RESC(); ROT();
    STEP(pA0,pA1,pB0,pB1,t+1,true,true,true);   WAIT_BAR(3); RESC(); ROT();
  }
  #undef CMASK
  #define CMASK(P0,P1,t) do{int jb_=(t)-(NT-4); if(jb_>=0)cmask(P0,P1,jb_,qrel,hi);}while(0)
  #define ENDW(tt) do{ if((tt)+3<NT){WAIT_BAR(3);} else if((tt)+2<NT){WAIT_BAR(2);} else {WAIT_BAR(0);} }while(0)
  for(;t+1<NT;t+=2){
    STEP(pB0,pB1,pA0,pA1,t,(t+3<NT),(t+1<NT),(t+1<NT));       ENDW(t);   RESC(); ROT();
    STEP(pA0,pA1,pB0,pB1,t+1,(t+4<NT),(t+2<NT),(t+2<NT));     ENDW(t+1); RESC(); ROT();
  }
  STEP(pB0,pB1,pA0,pA1,NT-1,false,false,false); RESC();
  { float sacc=pB0[0]+pB0[1]; _Pragma("unroll") for(int r=2;r<16;++r)sacc+=pB0[r]; _Pragma("unroll") for(int r=0;r<16;++r)sacc+=pB1[r]; l_reg+=sacc;
    pw0=(u32x4){PKW(pB0,0),PKW(pB0,2),PKW(pB0,4),PKW(pB0,6)};pw1=(u32x4){PKW(pB0,8),PKW(pB0,10),PKW(pB0,12),PKW(pB0,14)};pw2=(u32x4){PKW(pB1,0),PKW(pB1,2),PKW(pB1,4),PKW(pB1,6)};pw3=(u32x4){PKW(pB1,8),PKW(pB1,10),PKW(pB1,12),PKW(pB1,14)};
    SBAR(); pv(o,vb0+2*sl_cur,PAF(0),PAF(1),PAF(2),PAF(3)); }
  #undef PKW
  #undef PAF
  #undef VFR
  #undef PIN
  #undef MX3
  #undef GAPA
  #undef GAPB
  #undef EX
  #undef VRD
  #undef VRD2
  #undef KRD
  #undef STEP
  #undef ENDW
  {auto rr=__builtin_amdgcn_permlane32_swap(__float_as_uint(l_reg),__float_as_uint(l_reg),false,false);l_reg=__uint_as_float(rr[0])+__uint_as_float(rr[1]);}
  if(hi==0)wsf[32+r32]=l_reg;asm volatile("s_waitcnt lgkmcnt(0)":::"memory");
  float rli[16];
  #pragma unroll
  for(int r=0;r<16;++r)rli[r]=__builtin_amdgcn_rcpf(wsf[32+crow(r,hi)]);
  bf16*Ow=O+(rowbase+q0+wid*QBLK)*DM+colV;
  { bf16*stg=(bf16*)(shm+LDS_OST)+wid*2048;
    #pragma unroll
    for(int hf=0;hf<2;++hf){
      #pragma unroll
      for(int r=0;r<16;++r){const int orow=crow(r,hi);
        #pragma unroll
        for(int d0=0;d0<2;++d0)stg[orow*64+d0*32+r32]=__float2bfloat16(o[2*hf+d0][r]*rli[r]);}
      asm volatile("s_waitcnt lgkmcnt(0)":::"memory");
      #pragma unroll
      for(int i=0;i<4;++i){const int row=i*8+(lane>>3),ch=lane&7; const u32x4 v=*(const u32x4*)(stg+row*64+ch*8); ATTN_STORE16(Ow+(long)row*DM+hf*64+ch*8,v);}
      asm volatile("s_waitcnt lgkmcnt(0)":::"memory"); } }
  asm volatile("s_waitcnt lgkmcnt(0)\n\ts_barrier":::"memory");
  #undef DMA_K
  #undef DMA_V
  #undef CMASK
  #undef START
  #undef RESC
  #undef ROT
}
constexpr int ATTN_LDS_BYTES=LDS_BYTES;
#undef SBAR
#undef WAIT_BAR
}
constexpr int NWAVES = 8;
constexpr size_t MiB = 1u << 20;
constexpr size_t WS_CTL = 0, CTL_ZERO_BYTES = 64 * 1024;
constexpr size_t WS_SSQA = 1 * MiB, WS_SSQB = 2 * MiB;
constexpr size_t WS_SSQV = 3 * MiB;
constexpr size_t WS_SSQC = 4 * MiB + 512 * 1024;
constexpr size_t WS_ROPE = 5 * MiB;
constexpr size_t WS_WMIX = 9 * MiB, WS_W1 = 27 * MiB, WS_W2 = 35 * MiB;
constexpr size_t WS_XB = 43 * MiB;
constexpr size_t WS_ACT = 75 * MiB, WS_END = 267 * MiB;
constexpr int CW_BAR = 4096;
constexpr int RING_OFF = 0, RING_BYTES = 131072;
constexpr int LDSCTL_OFF = RING_BYTES, MISC_OFF = LDSCTL_OFF + 320;
constexpr int LDS_BYTES = 147456;
#define GAS __attribute__((address_space(1)))
#define LAS __attribute__((address_space(3)))
typedef unsigned short bf16;
typedef unsigned v4u __attribute__((ext_vector_type(4)));
typedef float f32x4 __attribute__((ext_vector_type(4)));
typedef short bf16x8 __attribute__((ext_vector_type(8)));
typedef GAS unsigned gu32;
typedef GAS unsigned long long gu64;
#define RLX_AGENT __ATOMIC_RELAXED, __HIP_MEMORY_SCOPE_AGENT
#define LDS_WAIT() asm volatile("s_waitcnt lgkmcnt(0)" ::: "memory")
#define VM_WAIT() asm volatile("s_waitcnt vmcnt(0)" ::: "memory")
__device__ __forceinline__ unsigned long long rt() { return __builtin_amdgcn_s_memrealtime(); }
__device__ __forceinline__ unsigned f2bf(float f) { unsigned u = __builtin_bit_cast(unsigned, f); return (u + 0x7fffu + ((u >> 16) & 1u)) >> 16; }
__device__ __forceinline__ unsigned pk2(float lo, float hi) { return f2bf(lo) | (f2bf(hi) << 16); }

#define XB_TMO      128
#define XB_XCNT(j)  (256  + 64 * (j))
#define XB_XSUB(j)  (1280 + 64 * (j))
#define XB_XGEN(j)  (2304 + 64 * (j))
#define XB_TOP      3328
#define XB_TOPGEN   3392
#define XCD_BAR_WORDS 3456
#define XB_SPIN_CAP (1u << 18)

__device__ __forceinline__ unsigned xb_ld(unsigned* p)              { return __hip_atomic_load(p, __ATOMIC_RELAXED, __HIP_MEMORY_SCOPE_AGENT); }
__device__ __forceinline__ unsigned xb_add(unsigned* p, unsigned v) { return __hip_atomic_fetch_add(p, v, __ATOMIC_RELAXED, __HIP_MEMORY_SCOPE_AGENT); }
__device__ __forceinline__ unsigned xb_xcc_id() { return (unsigned)__builtin_amdgcn_s_getreg((3 << 11) | 20) & 0xFu; }
#define XB_SPIN(cond, bar) do { unsigned _sp = 0; while (cond) { __builtin_amdgcn_s_sleep(1); \
    if ((++_sp & 255u) == 0u) { if (xb_ld(&(bar)[XB_TMO])) break; if (_sp > XB_SPIN_CAP) { atomicAdd(&(bar)[XB_TMO], 1u); break; } } } } while (0)

struct XcdBarrier {
    unsigned* bar; unsigned x;
    volatile LAS unsigned* st;
};

__device__ __forceinline__ XcdBarrier xcd_barrier_post(unsigned* bar, volatile LAS unsigned* st) {
    XcdBarrier b; b.bar = bar; b.x = xb_xcc_id(); b.st = st;
    if (threadIdx.x == 0) (void)xb_add(&bar[XB_XCNT(b.x)], 1u);
    return b;
}
__device__ __forceinline__ void xcd_barrier_complete(unsigned* bar, unsigned x, unsigned& nloc, unsigned& nx) {
    const unsigned G = gridDim.x * gridDim.y * gridDim.z;
    unsigned sum, cnt, mine, sp = 0u;
    for (;;) {
        sum = 0u; cnt = 0u; mine = 0u;
#pragma unroll
        for (unsigned j = 0; j < 16; ++j) { const unsigned c = xb_ld(&bar[XB_XCNT(j)]); sum += c; cnt += (c > 0u) ? 1u : 0u; mine = (j == x) ? c : mine; }
        if (sum == G) break;
        __builtin_amdgcn_s_sleep(1);
        if ((++sp & 255u) == 0u) { if (xb_ld(&bar[XB_TMO])) break; if (sp > XB_SPIN_CAP) { atomicAdd(&bar[XB_TMO], 1u); break; } }
    }
    nloc = mine > 0u ? mine : 1u; nx = cnt > 0u ? cnt : 1u;
}

__device__ __forceinline__ void xcd_barrier(const XcdBarrier& b) {
    asm volatile("s_waitcnt vmcnt(0)" ::: "memory");
    __syncthreads();
    if (threadIdx.x == 0) {
        unsigned* bar = b.bar;
        __builtin_amdgcn_s_waitcnt(0);
        unsigned nloc = b.st[0], nx = b.st[1];
        if (nloc == 0u) { xcd_barrier_complete(bar, b.x, nloc, nx); b.st[0] = nloc; b.st[1] = nx; }
        const unsigned old = xb_add(&bar[XB_XSUB(b.x)], 1u);
        const unsigned gen = old / nloc;
        if (old + 1u == (gen + 1u) * nloc) {
            __builtin_amdgcn_fence(__ATOMIC_RELEASE, "agent");
            asm volatile("s_waitcnt vmcnt(0)" ::: "memory");
            const unsigned og = xb_add(&bar[XB_TOP], 1u);
            const unsigned tg = og / nx;
            if (og + 1u == (tg + 1u) * nx) xb_add(&bar[XB_TOPGEN], 1u);
            else XB_SPIN(xb_ld(&bar[XB_TOPGEN]) == tg, bar);
            __builtin_amdgcn_fence(__ATOMIC_ACQUIRE, "agent");
            xb_add(&bar[XB_XGEN(b.x)], 1u);
            asm volatile("s_waitcnt vmcnt(0)" ::: "memory");
        } else {
            XB_SPIN(xb_ld(&bar[XB_XGEN(b.x)]) == gen, bar);
            __builtin_amdgcn_fence(__ATOMIC_ACQUIRE, "agent");
            asm volatile("s_waitcnt vmcnt(0)" ::: "memory");
        }
    }
    __syncthreads();
}
struct Args { const void* in[29]; float* out; unsigned char* ws; int ph_lo, ph_hi; };
struct Frame {
    LAS unsigned char* lds;
    volatile LAS unsigned* MISC;
    int tid, lane, wave, vcu, G;
};
typedef float f32x2v __attribute__((ext_vector_type(2)));
__device__ __forceinline__ float wave_sum(float v) {
#pragma unroll
    for (int o = 1; o < 64; o <<= 1) v += __shfl_xor(v, o);
    return v;
}
__device__ __forceinline__ void sincos_rev(double t, float& s, float& c) {
    t -= rint(t);
    const double k = rint(t * 4.0); const float f = (float)(t - k * 0.25), p = f * 6.2831853071795865f, p2 = p * p;
    const float sp = p * (1.0f + p2 * (-1.6666667163e-1f + p2 * (8.3333337680e-3f + p2 * (-1.9841270114e-4f + p2 * 2.7557314297e-6f))));
    const float cp = 1.0f + p2 * (-0.5f + p2 * (4.1666667908e-2f + p2 * (-1.3888889225e-3f + p2 * (2.4801587642e-5f + p2 * -2.7557314297e-7f))));
    const int q = ((int)k) & 3;
    s = (q == 0) ? sp : (q == 1) ? cp : (q == 2) ? -sp : -cp;
    c = (q == 0) ? cp : (q == 1) ? -sp : (q == 2) ? -cp : sp;
}
struct ConvJob { const float* W; int K, N; bf16* WT; const float* sv; int smask; float mul; int perm; };
__device__ __forceinline__ void transpose_item(const ConvJob& J, LAS float* scr, int item, int lane) {
    const int nblk = J.N / 32, kb = item / nblk, nb = item % nblk, k0 = 64 * kb, n0 = 32 * nb;
    f32x4 v[8];
    const float* src = J.W + (size_t)(k0 + (lane >> 3)) * J.N + n0 + 4 * (lane & 7);
#pragma unroll
    for (int i = 0; i < 8; ++i) v[i] = *(const f32x4*)(src + (size_t)(8 * i) * J.N);
    float sc[8];
#pragma unroll
    for (int i = 0; i < 8; ++i) { sc[i] = J.mul; if (J.sv) sc[i] *= J.sv[(k0 + 8 * i + (lane >> 3)) & J.smask]; }
#pragma unroll
    for (int i = 0; i < 8; ++i) { LAS float* d = scr + (8 * i + (lane >> 3)) * 33 + 4 * (lane & 7);
        d[0] = v[i][0] * sc[i]; d[1] = v[i][1] * sc[i]; d[2] = v[i][2] * sc[i]; d[3] = v[i][3] * sc[i]; }
    LDS_WAIT(); asm volatile("" ::: "memory");
    const int c = lane & 7;
#pragma unroll
    for (int j = 0; j < 4; ++j) { const int n = (lane >> 3) + 8 * j; const LAS float* s = scr + (8 * c) * 33 + n;
        v4u o; o.x = pk2(s[0 * 33], s[1 * 33]); o.y = pk2(s[2 * 33], s[3 * 33]); o.z = pk2(s[4 * 33], s[5 * 33]); o.w = pk2(s[6 * 33], s[7 * 33]);
        int nn = n0 + n; if (J.perm) { const int r = nn & 255; nn = (nn & ~255) + ((r >> 5) & 1) * 128 + (r >> 6) * 32 + (r & 31); }
        *(GAS v4u*)(J.WT + (size_t)nn * J.K + k0 + 8 * c) = o; }
    LDS_WAIT(); asm volatile("" ::: "memory");
}
__device__ __forceinline__ int conv_items(const ConvJob& J) { return (J.K / 64) * (J.N / 32); }
__device__ __forceinline__ void conv_run(Frame& F, const ConvJob& J0, const ConvJob& J1, const ConvJob& J2, const ConvJob& J3, const ConvJob& J4, int njobs) {
    LAS float* scr = (LAS float*)(F.lds + RING_OFF + F.wave * 16384);
    const int gw = F.vcu * NWAVES + F.wave, NGW = F.G * NWAVES;
    const int c0 = conv_items(J0), c1 = conv_items(J1), c2 = conv_items(J2), c3 = conv_items(J3), c4 = njobs > 4 ? conv_items(J4) : 0;
    const int total = c0 + c1 + c2 + c3 + c4;
    for (int it = gw; it < total; it += NGW) {
        int r = it;
        if (r < c0) { transpose_item(J0, scr, r, F.lane); continue; } r -= c0;
        if (r < c1) { transpose_item(J1, scr, r, F.lane); continue; } r -= c1;
        if (r < c2) { transpose_item(J2, scr, r, F.lane); continue; } r -= c2;
        if (r < c3) { transpose_item(J3, scr, r, F.lane); continue; } r -= c3;
        transpose_item(J4, scr, r, F.lane);
    }
}
[[maybe_unused]] __constant__ float INVF_TAB[32] = {1.000000000e+00f, 7.498942093e-01f, 5.623413252e-01f, 4.216965034e-01f, 3.162277660e-01f, 2.371373706e-01f, 1.778279410e-01f, 1.333521432e-01f, 1.000000000e-01f, 7.498942093e-02f, 5.623413252e-02f, 4.216965034e-02f, 3.162277660e-02f, 2.371373706e-02f, 1.778279410e-02f, 1.333521432e-02f, 1.000000000e-02f, 7.498942093e-03f, 5.623413252e-03f, 4.216965034e-03f, 3.162277660e-03f, 2.371373706e-03f, 1.778279410e-03f, 1.333521432e-03f, 1.000000000e-03f, 7.498942093e-04f, 5.623413252e-04f, 4.216965034e-04f, 3.162277660e-04f, 2.371373706e-04f, 1.778279410e-04f, 1.333521432e-04f};
__device__ __forceinline__ void init_phase(Frame& F, const float* x, bf16* XB, float* ssq0) {
    const int gw = F.vcu * NWAVES + F.wave, NGW = F.G * NWAVES;
    for (int m = gw; m < T_; m += NGW) {
        const GAS f32x4* xr = (const GAS f32x4*)(x + (size_t)m * 1024) + F.lane; GAS unsigned long long* o8 = (GAS unsigned long long*)(XB + (size_t)m * 1024) + F.lane;
        float s = 0.f;
#pragma unroll
        for (int j = 0; j < 4; ++j) { const f32x4 v = xr[64 * j]; s += (v.x * v.x + v.y * v.y) + (v.z * v.z + v.w * v.w);
            o8[64 * j] = (unsigned long long)pk2(v.x, v.y) | ((unsigned long long)pk2(v.z, v.w) << 32); }
        s = wave_sum(s); if (F.lane == 0) ssq0[m] = s;
    }
}
constexpr int ROWMETA_OFF = LDSCTL_OFF + 1024;
template <bool SLAB> __device__ __forceinline__ void stage_rowmeta(Frame& F, const float* ssq, const int* pos, int pm) {
    if (F.tid < 256) { const int row = pm * 256 + F.tid; LAS float* rsl = (LAS float*)(F.lds + ROWMETA_OFF);
        rsl[F.tid] = pg8::rs_of(SLAB ? pg8::slab16_sum(ssq, row) : ssq[row]);
        if (pos != nullptr) ((LAS int*)(F.lds + ROWMETA_OFF + 1024))[F.tid] = pos[row]; }
    __syncthreads();
}
__device__ __forceinline__ void compact_phase(Frame& F, const float* slab, float* compact) {
    const int gt = (F.vcu * NWAVES + F.wave) * 64 + F.lane, NGT = F.G * NWAVES * 64;
    for (int r = gt; r < T_; r += NGT) compact[r] = pg8::slab16_sum(slab, r);
}
struct AttnU { int b, cq, cv, qb, o2; };
struct AttnOrder { int vcu, G;
    __device__ __forceinline__ bool next(int idx, AttnU& u) const { const int n = vcu + G * (idx >> 2); if (n >= 256) return false; const int i = idx & 3, h = (n >> 3) & 7, s = n & 7, c = i >> 1;
        u.b = n >> 6; u.cq = (2 * h + c) * 64; u.cv = h * 128; u.qb = (i & 1) ? 15 - s : s; u.o2 = c; return true; } };
__device__ __forceinline__ void attn_phase(Frame& F, unsigned char* ldsg, const bf16* Q, const bf16* K, const bf16* V, bf16* O1, bf16* O2, const float* lam4, int layer, const float* qg, const float* kg) {
    float sh; { float a = fabsf(qg[F.lane]), b2 = fabsf(kg[F.lane]);
#pragma unroll
      for (int o = 1; o < 64; o <<= 1) { a = fmaxf(a, __shfl_xor(a, o)); b2 = fmaxf(b2, __shfl_xor(b2, o)); }
      const float mb = 64.0f * a * b2 * (0.125f * 1.4426950408889634f);
      sh = __uint_as_float(__builtin_amdgcn_readfirstlane(__float_as_uint(fmaxf(mb - 60.0f, 0.f)))); }
    { AttnU u; AttnOrder S{F.vcu, F.G};
      for (int idx = 0; S.next(idx, u); ++idx) attn_body::attn_unit<8>(u.b, u.cq, u.cv, u.qb, (const attn_body::bf16*)Q, (const attn_body::bf16*)K, (const attn_body::bf16*)V, (attn_body::bf16*)(u.o2 ? O2 : O1), (char*)ldsg, sh); }
    VM_WAIT(); __syncthreads();
    const float la_ = wave_sum(lam4[F.lane] * lam4[64 + F.lane]), lb_ = wave_sum(lam4[128 + F.lane] * lam4[192 + F.lane]);
    const float lam = __expf(la_) - __expf(lb_) + ((layer == 0) ? 0.2f : 0.55605820415f);
    for (int n = F.vcu; n < 256; n += F.G) {
        const int b = n >> 6, h = (n >> 3) & 7, s = n & 7;
        for (int it = F.tid >> 4; it < 512; it += 32) { const int qb = (it >> 8) ? 15 - s : s; const size_t off = ((size_t)b * SEQ + qb * 256 + (it & 255)) * 1024 + h * 128 + 8 * (F.tid & 15);
            const v4u w1 = *(const v4u*)(O1 + off), w2 = *(const v4u*)(O2 + off); float d[8]; float ss = 0.f;
#pragma unroll
            for (int e = 0; e < 8; ++e) { const unsigned x1 = w1[e >> 1], x2 = w2[e >> 1];
                const float f1 = (e & 1) ? __uint_as_float(x1 & 0xffff0000u) : __uint_as_float(x1 << 16), f2 = (e & 1) ? __uint_as_float(x2 & 0xffff0000u) : __uint_as_float(x2 << 16);
                d[e] = f1 - lam * f2; ss += d[e] * d[e]; }
            ss += __shfl_xor(ss, 1); ss += __shfl_xor(ss, 2); ss += __shfl_xor(ss, 4); ss += __shfl_xor(ss, 8);
            const float r = __builtin_amdgcn_rsqf(ss * (1.0f / 128.0f) + 1e-6f);
            v4u o; o.x = pk2(d[0] * r, d[1] * r); o.y = pk2(d[2] * r, d[3] * r); o.z = pk2(d[4] * r, d[5] * r); o.w = pk2(d[6] * r, d[7] * r);
            *(v4u*)(O1 + off) = o; }
    }
}
constexpr int SSM_KT = 0, SSM_BS = 9216, SSM_CC = 9216 + 65536, SSM_L16 = 9216 + 131072, SSM_TSTRIDE = 9216 + 131072 + 512;
__device__ __forceinline__ void ssm_tables(Frame& F, unsigned char* tabs, const float* a_re, const float* a_im, const float* b_re, const float* b_im, const float* c_re, const float* c_im, const float* log_dt) {
    LAS f32x2v* pw = (LAS f32x2v*)F.lds;
    LAS f32x2v* zo = pw + 17 * 64;
    LAS f32x2v* Bb = zo + 64;
    LAS f32x2v* Cc = Bb + 1024;
    for (int n = F.vcu; n < 256; n += F.G) {
        const int g = n & 63, q = n >> 6;
        if (F.tid < 64) { const int p = F.tid;
            const float are = fminf(a_re[g * 64 + p], -1e-4f), aim = a_im[g * 64 + p];
            const float dt = __expf(log_dt[g]), er = __expf(are * dt); float sn, cs; sincos_rev((double)aim * (double)dt * 0.15915494309189533577, sn, cs);
            const float lbr = er * cs, lbi = er * sn;
            const float nr = lbr - 1.0f, ni = lbi, den = are * are + aim * aim;
            zo[p] = (f32x2v){(nr * are + ni * aim) / den, (ni * are - nr * aim) / den};
            float pr = 1.f, pi = 0.f;
            for (int t = 0; t <= 16; ++t) { pw[t * 64 + p] = (f32x2v){pr, pi}; const float a = pr * lbr - pi * lbi, b2 = pr * lbi + pi * lbr; pr = a; pi = b2; } }
        __syncthreads();
        for (int e = F.tid; e < 1024; e += 512) { const f32x2v z = zo[e >> 4]; const float br = b_re[g * 1024 + e], bi = b_im[g * 1024 + e];
            Bb[e] = (f32x2v){z.x * br - z.y * bi, z.x * bi + z.y * br}; Cc[e] = (f32x2v){c_re[g * 1024 + e], c_im[g * 1024 + e]}; }
        __syncthreads();
        unsigned char* tg = tabs + (size_t)g * SSM_TSTRIDE;
        { bf16* kt = (bf16*)(tg + SSM_KT);
          for (int e = q * 1088 + F.tid; e < (q + 1) * 1088; e += 512) { const int lp1 = e >> 8, ho = (e >> 4) & 15, hi = e & 15; float acc = 0.f;
              if (lp1 > 0) for (int p = 0; p < 64; ++p) { const f32x2v c = Cc[ho * 64 + p], l = pw[(lp1 - 1) * 64 + p], b = Bb[p * 16 + hi];
                  const float tr = c.x * l.x - c.y * l.y, ti = c.x * l.y + c.y * l.x; acc += tr * b.x - ti * b.y; }
              kt[e] = (bf16)f2bf(acc); }
          if (q == 0 && F.tid < 64) ((f32x2v*)(tg + SSM_L16))[F.tid] = pw[16 * 64 + F.tid]; }
        { bf16* bs = (bf16*)(tg + SSM_BS);
          for (int e = q * 8192 + F.tid; e < (q + 1) * 8192; e += 512) { const int r = e >> 8, k = e & 255, i = k >> 4, hi = k & 15, p = r & 63;
              const f32x2v l = pw[(15 - i) * 64 + p], b = Bb[p * 16 + hi]; const float mr = l.x * b.x - l.y * b.y, mi = l.x * b.y + l.y * b.x;
              bs[e] = (bf16)f2bf((r >> 6) ? mi : mr); } }
        { bf16* cc = (bf16*)(tg + SSM_CC);
          for (int e = q * 8192 + F.tid; e < (q + 1) * 8192; e += 512) { const int row = e >> 7, k = e & 127, jj = row >> 4, ho = row & 15, p = k >> 1;
              const f32x2v c = Cc[ho * 64 + p], l = pw[(jj + 1) * 64 + p]; const float mr = c.x * l.x - c.y * l.y, mi = c.x * l.y + c.y * l.x;
              cc[e] = (bf16)f2bf((k & 1) ? -mi : mr); } }
        __syncthreads();
    }
}
#ifndef DBG_SSM_SKIP
#define DBG_SSM_SKIP 0
#endif
#define SSM_DBG(bit) (dbg && ((DBG_SSM_SKIP >> (bit)) & 1))
__device__ __forceinline__ void ssm_phase(Frame& F, const bf16* U, bf16* GA, const unsigned char* tabs, const float* dsk, const int dbg) {
    const int lane = F.lane, w = F.wave, lr = lane & 15, kq = lane >> 4;
    LAS unsigned short* Ul = (LAS unsigned short*)F.lds;
    LAS float* El = (LAS float*)(F.lds + 33792);
    LAS unsigned short* Sb = (LAS unsigned short*)(F.lds + 33792 + 33280);
    LAS unsigned short* Kt = (LAS unsigned short*)(F.lds + 33792 + 33280 + 17408);
    for (int item = F.vcu; item < (SSM_DBG(4) ? 0 : 256); item += F.G) {
        const int b = item >> 6, g = item & 63;
        const unsigned char* tg = tabs + (size_t)g * SSM_TSTRIDE;
        for (int q = F.tid; q < 544; q += 512) *(LAS v4u*)(Kt + q * 8) = *(const v4u*)(tg + SSM_KT + q * 16);
        bf16x8 Abs[8], Acc[2][4];
#pragma unroll
        for (int ks = 0; ks < 8; ++ks) Abs[ks] = *(const bf16x8*)(tg + SSM_BS + ((16 * w + lr) * 256 + 32 * ks + 8 * kq) * 2);
#pragma unroll
        for (int jj = 0; jj < 2; ++jj) { const int j = jj ? 15 - w : w;
#pragma unroll
            for (int ks = 0; ks < 4; ++ks) Acc[jj][ks] = *(const bf16x8*)(tg + SSM_CC + ((j * 16 + lr) * 128 + 32 * ks + 8 * kq) * 2); }
        const f32x2v l16 = ((const f32x2v*)(tg + SSM_L16))[lane];
        const f32x4 dskv = *(const f32x4*)(dsk + g * 16 + 4 * kq);
        float sre = 0.f, sim = 0.f;
        const size_t rowbase = (size_t)b * SEQ;
        v4u upre[4];
#pragma unroll
        for (int i = 0; i < 4; ++i) { const int q = F.tid + 512 * i; upre[i] = *(const v4u*)(U + (rowbase + (q >> 1)) * 1024 + g * 16 + (q & 1) * 8); }
        for (int seg = 0; seg < 4; ++seg) {
#pragma unroll
            for (int i = 0; i < 4; ++i) { const int q = F.tid + 512 * i, t = q >> 1, hf = q & 1; *(LAS v4u*)(Ul + (t >> 4) * 264 + (t & 15) * 16 + hf * 8) = upre[i]; }
            if (seg < 3) {
#pragma unroll
                for (int i = 0; i < 4; ++i) { const int q = F.tid + 512 * i; upre[i] = *(const v4u*)(U + (rowbase + (seg + 1) * 1024 + (q >> 1)) * 1024 + g * 16 + (q & 1) * 8); } }
            __syncthreads();
            if (!SSM_DBG(3)) { f32x4 acc[4];
#pragma unroll
              for (int nb = 0; nb < 4; ++nb) acc[nb] = (f32x4){0.f, 0.f, 0.f, 0.f};
#pragma unroll
              for (int ks = 0; ks < 8; ++ks)
#pragma unroll
                  for (int nb = 0; nb < 4; ++nb) { const bf16x8 Bf = *(const LAS bf16x8*)(Ul + (16 * nb + lr) * 264 + (2 * ks + (kq >> 1)) * 16 + (kq & 1) * 8);
                      acc[nb] = __builtin_amdgcn_mfma_f32_16x16x32_bf16(Abs[ks], Bf, acc[nb], 0, 0, 0); }
#pragma unroll
              for (int nb = 0; nb < 4; ++nb)
#pragma unroll
                  for (int r = 0; r < 4; ++r) El[(16 * w + 4 * kq + r) * 65 + 16 * nb + lr] = acc[nb][r]; }
            __syncthreads();
            if (w == 0 && !SSM_DBG(0)) {
                for (int k0 = 0; k0 < 64; k0 += 16) { float er[16], ei[16];
#pragma unroll
                    for (int kk = 0; kk < 16; ++kk) { er[kk] = El[lane * 65 + k0 + kk]; ei[kk] = El[(64 + lane) * 65 + k0 + kk]; }
#pragma unroll
                    for (int kk = 0; kk < 16; ++kk) { *(LAS unsigned*)(Sb + (k0 + kk) * 136 + 2 * lane) = pg8::cvt_pk_bf16(sre, sim);
                        const float a = l16.x * sre - l16.y * sim + er[kk], b2 = l16.x * sim + l16.y * sre + ei[kk]; sre = a; sim = b2; } } }
            __syncthreads();
#pragma unroll
            for (int jj = 0; jj < 2; ++jj) { const int j = jj ? 15 - w : w;
                f32x4 acc[4];
#pragma unroll
                for (int nb = 0; nb < 4; ++nb) acc[nb] = (f32x4){0.f, 0.f, 0.f, 0.f};
                if (!SSM_DBG(1)) { bf16x8 Af[8];
#pragma unroll
                for (int ks = 0; ks < 8; ++ks) { int lp1 = j - 2 * ks - (kq >> 1) + 1; lp1 = lp1 < 0 ? 0 : lp1; Af[ks] = *(const LAS bf16x8*)(Kt + lp1 * 256 + lr * 16 + (kq & 1) * 8); }
#pragma unroll
                for (int nb = 0; nb < 4; ++nb) { bf16x8 Bf[8];
#pragma unroll
                    for (int ks = 0; ks < 8; ++ks) Bf[ks] = *(const LAS bf16x8*)(Ul + (16 * nb + lr) * 264 + (2 * ks + (kq >> 1)) * 16 + (kq & 1) * 8);
#pragma unroll
                    for (int ks = 0; ks < 8; ++ks) acc[nb] = __builtin_amdgcn_mfma_f32_16x16x32_bf16(Af[ks], Bf[ks], acc[nb], 0, 0, 0);
                    asm volatile("" ::: "memory"); } }
#pragma unroll
                for (int ks = 0; ks < 4; ++ks)
#pragma unroll
                    for (int nb = 0; nb < 4; ++nb) { const bf16x8 Bf = *(const LAS bf16x8*)(Sb + (16 * nb + lr) * 136 + 32 * ks + 8 * kq);
                        acc[nb] = __builtin_amdgcn_mfma_f32_16x16x32_bf16(Acc[jj][ks], Bf, acc[nb], 0, 0, 0); }
#pragma unroll
                for (int nb = 0; nb < 4; ++nb) { const int n = 16 * nb + lr; const int ts = 16 * n + j;
                    const unsigned long long uu = *(const LAS unsigned long long*)(Ul + n * 264 + j * 16 + 4 * kq);
                    const float u0 = __uint_as_float((unsigned)uu << 16), u1 = __uint_as_float((unsigned)uu & 0xffff0000u), u2 = __uint_as_float((unsigned)(uu >> 32) << 16), u3 = __uint_as_float((unsigned)(uu >> 32) & 0xffff0000u);
                    const float y0 = pg8::gelu_tanh(acc[nb][0] + dskv[0] * u0), y1 = pg8::gelu_tanh(acc[nb][1] + dskv[1] * u1), y2 = pg8::gelu_tanh(acc[nb][2] + dskv[2] * u2), y3 = pg8::gelu_tanh(acc[nb][3] + dskv[3] * u3);
                    if (!SSM_DBG(2)) *(unsigned long long*)(GA + (rowbase + seg * 1024 + ts) * 1024 + g * 16 + 4 * kq) = (unsigned long long)pk2(y0, y1) | ((unsigned long long)pk2(y2, y3) << 32); } }
            __syncthreads();
        }
    }
}
__device__ __forceinline__ void gate_phase(Frame& F, bf16* ZU, const bf16* ZVT, const float* ssqv, const float* Ws, const float* bs, const float* vg) {
    LAS unsigned short* Al = (LAS unsigned short*)F.lds;
    const int lane = F.lane, lr = lane & 15, kq = lane >> 4, s = F.tid & 127, t0 = F.tid >> 7;
    bf16x8 Bf[3][4]; float wv[32];
#define GATE_PREFETCH(nn) do { const int h_ = (nn) & 7, tok_ = ((nn) >> 8) * SEQ + (((nn) >> 3) & 31) * 128, dw_ = h_ * 384 + 48 * F.wave; \
        _Pragma("unroll") for (int db = 0; db < 3; ++db) _Pragma("unroll") for (int ks = 0; ks < 4; ++ks) Bf[db][ks] = *(const bf16x8*)(ZVT + (size_t)(dw_ + 16 * db + lr) * T_ + tok_ + 32 * ks + 8 * kq); \
        _Pragma("unroll") for (int k = 0; k < 32; ++k) wv[k] = Ws[(size_t)(h_ * 128 + t0 + 4 * k) * 128 + s]; } while (0)
    int n = F.vcu;
    if (n < 1024) GATE_PREFETCH(n);
    for (; n < 1024; n += F.G) {
        const int b = n >> 8, ch = (n >> 3) & 31, h = n & 7; const int tok0 = b * SEQ + ch * 128;
        const int dw = h * 384 + 48 * F.wave;
        unsigned long long uu[8][3];
#pragma unroll
        for (int tb = 0; tb < 8; ++tb)
#pragma unroll
            for (int db = 0; db < 3; ++db) uu[tb][db] = *(const unsigned long long*)(ZU + (size_t)(tok0 + 16 * tb + lr) * GH + dw + 16 * db + 4 * kq);
        { const f32x4* sp = (const f32x4*)(ssqv + (size_t)(tok0 + s) * 24); float sv = 0.f;
#pragma unroll
          for (int q = 0; q < 6; ++q) { const f32x4 a = sp[q]; sv += (a[0] + a[1]) + (a[2] + a[3]); }
          const float rv = __builtin_amdgcn_rsqf(sv * (1.0f / 3072.0f) + 1e-6f);
#pragma unroll
          for (int k = 0; k < 32; ++k) { const int t = t0 + 4 * k; Al[t * 136 + s] = (unsigned short)f2bf((s <= t) ? wv[k] * rv : 0.f); } }
        __syncthreads();
        bf16x8 Bc[3][4];
#pragma unroll
        for (int db = 0; db < 3; ++db)
#pragma unroll
            for (int ks = 0; ks < 4; ++ks) Bc[db][ks] = Bf[db][ks];
        if (n + F.G < 1024) GATE_PREFETCH(n + F.G);
#pragma unroll
        for (int tb = 0; tb < 8; ++tb) {
            f32x4 acc[3];
#pragma unroll
            for (int db = 0; db < 3; ++db) acc[db] = (f32x4){0.f, 0.f, 0.f, 0.f};
#pragma unroll
            for (int ks = 0; ks < 4; ++ks) if (ks <= tb / 2) {
                const bf16x8 Af = *(const LAS bf16x8*)(Al + (16 * tb + lr) * 136 + 32 * ks + 8 * kq);
#pragma unroll
                for (int db = 0; db < 3; ++db) acc[db] = __builtin_amdgcn_mfma_f32_16x16x32_bf16(Bc[db][ks], Af, acc[db], 0, 0, 0); }
            const int t = 16 * tb + lr; const float bsv = bs[h * 128 + t];
#pragma unroll
            for (int db = 0; db < 3; ++db) { const int dcol = dw + 16 * db + 4 * kq; const f32x4 gv = *(const f32x4*)(vg + dcol); const unsigned long long u8 = uu[tb][db];
                const float u0 = __uint_as_float((unsigned)u8 << 16), u1 = __uint_as_float((unsigned)u8 & 0xffff0000u), u2 = __uint_as_float((unsigned)(u8 >> 32) << 16), u3 = __uint_as_float((unsigned)(u8 >> 32) & 0xffff0000u);
                const float o0 = u0 * (acc[db][0] * gv[0] + bsv), o1 = u1 * (acc[db][1] * gv[1] + bsv), o2 = u2 * (acc[db][2] * gv[2] + bsv), o3 = u3 * (acc[db][3] * gv[3] + bsv);
                *(unsigned long long*)(ZU + (size_t)(tok0 + t) * GH + dcol) = (unsigned long long)pk2(o0, o1) | ((unsigned long long)pk2(o2, o3) << 32); }
        }
        __syncthreads();
    }
#undef GATE_PREFETCH
}
__device__ __forceinline__ bool step_exists(int st) { return !((st % 7) == 3 && ((st / 7) % 3) != 1); }
typedef const __attribute__((address_space(4))) char* kargp_t;
__device__ __forceinline__ kargp_t kargs() { kargp_t kp = (kargp_t)__builtin_amdgcn_kernarg_segment_ptr(); asm volatile("" : "+s"(kp)); return kp; }
#define ARGP(i) (*(const void* const __attribute__((address_space(4)))*)(kp + 8 * (i)))
#define ARGI(off) (*(const int __attribute__((address_space(4)))*)(kp + (off)))
__device__ __forceinline__ void run_step(const int st, unsigned char* lds, const int rep) {
    kargp_t kp = kargs();
    Frame F;
    F.lds = (LAS unsigned char*)lds; asm volatile("" : "+s"(F.lds));
    F.MISC = (volatile LAS unsigned*)(F.lds + MISC_OFF);
    F.tid = tid_fresh(); F.G = gridDim.x; int bx = blockIdx.x;
    asm volatile("" : "+s"(F.G), "+s"(bx));
    F.lane = F.tid & 63; F.wave = __builtin_amdgcn_readfirstlane(F.tid >> 6);
    F.vcu = (F.G % 8 == 0) ? (bx % 8) * (F.G / 8) + bx / 8 : bx;
    unsigned char* ws = (unsigned char*)ARGP(30);
    bf16* WMIX = (bf16*)(ws + WS_WMIX); bf16* XB = (bf16*)(ws + WS_XB);
    unsigned char* act = ws + WS_ACT;
    const int layer = st / 7, slot = st % 7, kind = layer % 3, j = layer / 3;
    float* ssq_in = (float*)(ws + WS_SSQC);
    float* ssq_mid = (float*)(ws + WS_SSQB);
    float* ssq_out = (float*)(ws + WS_SSQA);
    float* ssqv = (float*)(ws + WS_SSQV);
    if (slot == 0) {
        const float* norm_mix = (const float*)ARGP(2); const float* norm_mlp = (const float*)ARGP(3);
        ConvJob J0{}, J1{}, J2{}, J3{}, J4{}; int nj = 4;
        if (kind == 0) {
            J0 = ConvJob{(const float*)ARGP(6) + (size_t)j * 1024 * 3072, 1024, 3072, WMIX, norm_mix + layer * 1024, 1023, 1.f, 1};
            J1 = ConvJob{(const float*)ARGP(11) + (size_t)j * 1024 * 1024, 1024, 1024, WMIX + 3 * MiB, (const float*)ARGP(10) + j * 128, 127, (layer == 0) ? 0.8f : 0.44394179585f, 0};
        } else if (kind == 1) {
            J0 = ConvJob{(const float*)ARGP(12) + (size_t)j * 1024 * 1024, 1024, 1024, WMIX, norm_mix + layer * 1024, 1023, 1.f, 0};
            J1 = ConvJob{(const float*)ARGP(21) + (size_t)j * 1024 * 1024, 1024, 1024, WMIX + 1 * MiB, nullptr, 0, 1.f, 0};
            J4 = ConvJob{(const float*)ARGP(23) + (size_t)j * 1024 * 1024, 1024, 1024, WMIX + 2 * MiB, nullptr, 0, 1.f, 0}; nj = 5;
        } else {
            J0 = ConvJob{(const float*)ARGP(24) + (size_t)j * 1024 * 6144, 1024, 6144, WMIX, norm_mix + layer * 1024, 1023, 1.f, 0};
            J1 = ConvJob{(const float*)ARGP(28) + (size_t)j * 3072 * 1024, 3072, 1024, WMIX + 6 * MiB, nullptr, 0, 1.f, 0};
        }
        J2 = ConvJob{(const float*)ARGP(4) + (size_t)layer * 1024 * 4096, 1024, 4096, (bf16*)(ws + WS_W1), norm_mlp + layer * 1024, 1023, 1.f, 0};
        J3 = ConvJob{(const float*)ARGP(5) + (size_t)layer * 4096 * 1024, 4096, 1024, (bf16*)(ws + WS_W2), nullptr, 0, 1.f, 0};
        conv_run(F, J0, J1, J2, J3, J4, nj);
        if (layer == 0) init_phase(F, (const float*)ARGP(0), XB, ssq_in);
        else compact_phase(F, ssq_out, ssq_in);
        if (kind == 1) ssm_tables(F, act + 96 * MiB, (const float*)ARGP(13) + j * 4096, (const float*)ARGP(14) + j * 4096, (const float*)ARGP(15) + (size_t)j * 65536, (const float*)ARGP(16) + (size_t)j * 65536,
                                  (const float*)ARGP(17) + (size_t)j * 65536, (const float*)ARGP(18) + (size_t)j * 65536, (const float*)ARGP(20) + j * 64);
    } else if (slot == 1) {
        const LAS float* rsl = (const LAS float*)(F.lds + ROWMETA_OFF); const LAS int* posl = (const LAS int*)(F.lds + ROWMETA_OFF + 1024);
        if (kind == 0) {
            pg8::Gemm g{XB, WMIX, T_, 3072, 1024}; pg8::StaticOrder S; S.init(T_, 3072, F.G, bx);
            { pg8::Unit u0; S.next(0, u0); stage_rowmeta<false>(F, ssq_in, (const int*)ARGP(1), u0.pm); }
            pg8::EpiQKV E{(bf16*)act, (bf16*)(act + 32 * MiB), (bf16*)(act + 64 * MiB), rsl, posl, (const float*)ARGP(7) + j * 64, (const float*)ARGP(8) + j * 64};
            pg8::gemm_phase<pg8::EpiQKV, pg8::StaticOrder, true, true>(F.lds + RING_OFF, g, S, E);
        } else if (kind == 1) {
            pg8::Gemm g{XB, WMIX, T_, 1024, 1024}; pg8::StaticOrder S; S.init(T_, 1024, F.G, bx);
            { pg8::Unit u0; S.next(0, u0); stage_rowmeta<false>(F, ssq_in, nullptr, u0.pm); }
            pg8::EpiRowScale<0> E{(bf16*)act, 1024, rsl, 0};
            pg8::gemm_phase<pg8::EpiRowScale<0>, pg8::StaticOrder, true, true>(F.lds + RING_OFF, g, S, E);
        } else {
            { pg8::Gemm g{XB, WMIX, T_, GH, 1024}; pg8::StaticOrder S; S.init(T_, GH, F.G, bx);
              { pg8::Unit u0; S.next(0, u0); stage_rowmeta<false>(F, ssq_in, nullptr, u0.pm); }
              pg8::EpiRowScale<2> E{(bf16*)act, GH, rsl, 0};
              pg8::gemm_phase<pg8::EpiRowScale<2>, pg8::StaticOrder, true, true>(F.lds + RING_OFF, g, S, E); }
            { pg8::Gemm g{WMIX + (size_t)GH * 1024, XB, GH, T_, 1024}; pg8::StaticOrder S; S.init(GH, T_, F.G, bx);
              pg8::EpiGmV E{(bf16*)(act + 96 * MiB), T_, ssq_in, ssqv};
              pg8::gemm_phase<pg8::EpiGmV, pg8::StaticOrder, true, true>(F.lds + RING_OFF, g, S, E); }
        }
    } else if (slot == 2) {
        if (kind == 0) attn_phase(F, lds + RING_OFF, (const bf16*)act, (const bf16*)(act + 32 * MiB), (const bf16*)(act + 64 * MiB), (bf16*)(act + 96 * MiB), (bf16*)(act + 128 * MiB),
                                  (const float*)ARGP(9) + j * 256, layer, (const float*)ARGP(7) + j * 64, (const float*)ARGP(8) + j * 64);
        else if (kind == 1) ssm_phase(F, (const bf16*)act, (bf16*)(act + (rep ? 64 : 32) * MiB), act + 96 * MiB, (const float*)ARGP(19) + j * 1024, rep);
        else gate_phase(F, (bf16*)act, (const bf16*)(act + 96 * MiB), ssqv, (const float*)ARGP(26) + (size_t)j * 8 * 128 * 128, (const float*)ARGP(27) + j * 1024, (const float*)ARGP(25) + j * GH);
    } else if (slot == 3) {
        pg8::Gemm g{(const bf16*)(act + 32 * MiB), WMIX + 1 * MiB, T_, 1024, 1024}; pg8::StaticOrder S; S.init(T_, 1024, F.G, bx);
        pg8::EpiGlu E{(bf16*)(act + 64 * MiB), (const bf16*)(act + 32 * MiB), (const float*)ARGP(22) + j * 1024};
        pg8::gemm_phase<pg8::EpiGlu, pg8::StaticOrder, true, true>(F.lds + RING_OFF, g, S, E);
    } else if (slot == 4 || slot == 6) {
        float* out = (st == 27) ? (float*)ARGP(29) : nullptr;
        const bf16* A; const bf16* Bt; int K; float* sq;
        if (slot == 6) { A = (const bf16*)act; Bt = (const bf16*)(ws + WS_W2); K = 4096; sq = (layer < 3) ? ssq_out : nullptr; }
        else { sq = ssq_mid;
            if (kind == 0) { A = (const bf16*)(act + 96 * MiB); Bt = WMIX + 3 * MiB; K = 1024; }
            else if (kind == 1) { A = (const bf16*)(act + 64 * MiB); Bt = WMIX + 2 * MiB; K = 1024; }
            else { A = (const bf16*)act; Bt = WMIX + 6 * MiB; K = GH; } }
        pg8::Gemm g{A, Bt, T_, 1024, K}; pg8::StaticOrder S; S.init(T_, 1024, F.G, bx);
        pg8::EpiRes E{out, XB, sq};
        pg8::gemm_phase<pg8::EpiRes, pg8::StaticOrder, true, true>(F.lds + RING_OFF, g, S, E);
    } else {
        pg8::Gemm g{XB, (const bf16*)(ws + WS_W1), T_, FF, 1024}; pg8::StaticOrder S; S.init(T_, FF, F.G, bx);
#ifdef DBG_MLP1_UNITS
        if (rep) S.nwg = 256 * DBG_MLP1_UNITS;
#endif
        { pg8::Unit u0; S.next(0, u0); stage_rowmeta<true>(F, ssq_mid, nullptr, u0.pm); }
#ifdef DBG_STAGGER
        { const unsigned long long t0_ = __builtin_amdgcn_s_memrealtime(); const unsigned long long dl_ = (unsigned long long)(F.vcu >> 5) * DBG_STAGGER; while (__builtin_amdgcn_s_memrealtime() - t0_ < dl_) __builtin_amdgcn_s_sleep(4); }
#endif
        pg8::EpiRowScale<1> E{(bf16*)act, FF, (const LAS float*)(F.lds + ROWMETA_OFF), rep};
        pg8::gemm_phase<pg8::EpiRowScale<1>, pg8::StaticOrder, true, true>(F.lds + RING_OFF, g, S, E);
    }
}
__global__ void __launch_bounds__(NWAVES * 64, 2) trunk_fwd(Args args) {
    extern __shared__ __attribute__((aligned(16))) unsigned char lds[];
    for (int u = threadIdx.x; u < (LDS_BYTES - LDSCTL_OFF) / 4; u += NWAVES * 64) ((LAS unsigned*)((LAS unsigned char*)lds + LDSCTL_OFF))[u] = 0u;
    __syncthreads();
    if (args.ph_hi - args.ph_lo > 1) (void)xcd_barrier_post((unsigned*)((gu32*)(args.ws + WS_CTL) + CW_BAR), (volatile LAS unsigned*)((LAS unsigned char*)lds + MISC_OFF) + 8);
    int st = args.ph_lo;
#ifndef DBG_REPEAT_MASK
#define DBG_REPEAT_MASK 0u
#endif
    int rep = 0;
    for (;;) {
        { kargp_t kp = kargs(); if (st >= ARGI(252)) break; }
        if (step_exists(st)) {
#ifdef DBG_TIME_STEP
#ifndef DBG_TIME_BLOCK
#define DBG_TIME_BLOCK 0
#endif
#ifndef DBG_TIME_REP
#define DBG_TIME_REP 0
#endif
            unsigned long long tc0_ = 0, tr0_ = 0; if (st == DBG_TIME_STEP && rep == DBG_TIME_REP) { tc0_ = __builtin_amdgcn_s_memtime(); tr0_ = __builtin_amdgcn_s_memrealtime(); }
#ifdef DBG_TIME_INCL_BAR
            if (st == DBG_TIME_STEP && blockIdx.x == DBG_TIME_BLOCK && threadIdx.x == 0) { volatile LAS unsigned* M_ = (volatile LAS unsigned*)((LAS unsigned char*)lds + MISC_OFF); M_[18] = (unsigned)tr0_; }
            if (st == DBG_TIME_STEP + DBG_TIME_INCL_BAR && blockIdx.x == DBG_TIME_BLOCK && threadIdx.x == 0) { volatile LAS unsigned* M_ = (volatile LAS unsigned*)((LAS unsigned char*)lds + MISC_OFF); M_[19] = (unsigned)__builtin_amdgcn_s_memrealtime() - M_[18]; }
#endif
#endif
            run_step(st, lds, rep);
#ifdef DBG_TIME_STEP
            if (st == DBG_TIME_STEP && rep == DBG_TIME_REP && blockIdx.x == DBG_TIME_BLOCK && threadIdx.x == 0) { const unsigned long long tc1_ = __builtin_amdgcn_s_memtime(), tr1_ = __builtin_amdgcn_s_memrealtime();
                volatile LAS unsigned* M_ = (volatile LAS unsigned*)((LAS unsigned char*)lds + MISC_OFF); M_[16] = (unsigned)(tc1_ - tc0_); M_[17] = (unsigned)(tr1_ - tr0_); }
#endif
            kargp_t kp = kargs();
            if (st + 1 < ARGI(252) || (DBG_REPEAT_MASK != 0u && ((DBG_REPEAT_MASK >> st) & 1u))) { XcdBarrier bar; bar.bar = (unsigned*)((gu32*)((unsigned char*)ARGP(30) + WS_CTL) + CW_BAR); bar.x = xb_xcc_id(); bar.st = (volatile LAS unsigned*)((LAS unsigned char*)lds + MISC_OFF) + 8;
                xcd_barrier(bar); }
        }
#ifndef DBG_REPEAT_N
#define DBG_REPEAT_N 1
#endif
        if (DBG_REPEAT_MASK != 0u && rep < DBG_REPEAT_N && ((DBG_REPEAT_MASK >> st) & 1u)) ++rep; else { rep = 0; ++st; }
    }
#ifdef DBG_TIME_STEP
    if (blockIdx.x == DBG_TIME_BLOCK && threadIdx.x == 0) { volatile LAS unsigned* M_ = (volatile LAS unsigned*)((LAS unsigned char*)lds + MISC_OFF); const unsigned cyc = M_[16];
#ifdef DBG_TIME_INCL_BAR
        const unsigned rt = M_[19];
#else
        const unsigned rt = M_[17];
#endif
        unsigned long long wait_ticks = (DBG_TIME_MODE == 0) ? (unsigned long long)rt * 10ull : (unsigned long long)(((double)cyc / (double)rt) * 10000.0);
        const unsigned long long t0 = __builtin_amdgcn_s_memrealtime(); while (__builtin_amdgcn_s_memrealtime() - t0 < wait_ticks) __builtin_amdgcn_s_sleep(16); }
#endif
}

#ifdef DBG_DUMP_OFF
__global__ void dbg_dump(const unsigned short* src, float* out, int n) { for (int i = blockIdx.x * blockDim.x + threadIdx.x; i < n; i += gridDim.x * blockDim.x) out[i] = __uint_as_float((unsigned)src[i] << 16); }
#endif
#ifndef MK_PER_PHASE
#define MK_PER_PHASE 0
#endif
extern "C" void kernel_launch(void* const* d_in, const int* in_sizes, int n_in, void* d_out, int out_size, void* d_ws, size_t ws_size, hipStream_t stream) {
    static int grid = 0;
    static_assert(sizeof(Args) == 256, "Args layout: in[29] at 0, out at 232, ws at 240, ph_lo 248, ph_hi 252");
    if (grid == 0) {
        if (n_in != 29 || in_sizes[0] != T_ * 1024 || out_size != T_ * 1024 || ws_size < WS_END) { fprintf(stderr, "kernel_launch: unexpected shapes / workspace (n_in %d, ws %zu); nothing launched\n", n_in, ws_size); grid = -1; return; }
        int dev = 0, cus = 0;
        if (hipGetDevice(&dev) != hipSuccess || hipDeviceGetAttribute(&cus, hipDeviceAttributeMultiprocessorCount, dev) != hipSuccess) { grid = -1; return; }
        if (hipFuncSetAttribute((const void*)trunk_fwd, hipFuncAttributeMaxDynamicSharedMemorySize, LDS_BYTES) != hipSuccess) { fprintf(stderr, "kernel_launch: hipFuncSetAttribute failed\n"); grid = -1; return; }
        int per_cu = 0; (void)hipOccupancyMaxActiveBlocksPerMultiprocessor(&per_cu, (const void*)trunk_fwd, NWAVES * 64, LDS_BYTES); (void)hipGetLastError();
        if (per_cu < 1) fprintf(stderr, "kernel_launch: occupancy query reports %d blocks per CU\n", per_cu);
        if (cus != 256) { fprintf(stderr, "kernel_launch: built for a 256-CU device (one 256-row panel per workgroup in the GEMM phases); this device reports %d CUs; nothing launched\n", cus); grid = -1; return; }
        grid = cus;
    }
    if (grid < 0) return;
    (void)hipMemsetAsync((char*)d_ws + WS_CTL, 0, CTL_ZERO_BYTES, stream);
    Args a{};
    for (int i = 0; i < 29; ++i) a.in[i] = d_in[i];
    a.out = (float*)d_out; a.ws = (unsigned char*)d_ws;
#ifndef DBG_LAST_STEP
#define DBG_LAST_STEP 27
#endif
#if MK_PER_PHASE
    for (int st = 0; st <= DBG_LAST_STEP; ++st) { if ((st % 7) == 3 && ((st / 7) % 3) != 1) continue; a.ph_lo = st; a.ph_hi = st + 1;
        hipLaunchKernelGGL(trunk_fwd, dim3(grid), dim3(NWAVES * 64), LDS_BYTES, stream, a); }
#ifdef DBG_DUMP_OFF
    hipLaunchKernelGGL(dbg_dump, dim3(2048), dim3(256), 0, stream, (const unsigned short*)((const char*)d_ws + (size_t)(DBG_DUMP_OFF)), (float*)d_out, T_ * 1024);
#endif
#else
    a.ph_lo = 0; a.ph_hi = 28;
    hipLaunchKernelGGL(trunk_fwd, dim3(grid), dim3(NWAVES * 64), LDS_BYTES, stream, a);
#endif
}
```

```cpp
#include <hip/hip_runtime.h>
#include <hip/hip_bf16.h>
#include <cstdio>
#include <cstdint>
#include <cmath>

constexpr int BATCH = 4, SEQ = 4096, DM_ = 1024, T_ = BATCH * SEQ;
constexpr int FF = 4096, GF = 6144, GH = 3072;
constexpr float EPS_ = 1e-6f;

__device__ __forceinline__ int tid_fresh() { int t = threadIdx.x; asm volatile("" : "+v"(t)); return t; }

namespace pg8 {
#define PG8_LAS __attribute__((address_space(3)))
typedef unsigned short bf16_t;
typedef short bf16x8 __attribute__((ext_vector_type(8)));
typedef float f32x4 __attribute__((ext_vector_type(4)));
typedef unsigned u32x4 __attribute__((ext_vector_type(4)));
constexpr int BM = 256, BK = 64, HALF = 128, HTB = HALF * BK * 2  , STAGE_BYTES = 8 * HTB, NXCD = 8, WGM = 8;

__host__ __device__ __forceinline__ int lds_byte(int r, int c) { const int st = (r >> 4) * 2 + (c >> 5), rr = r & 15, cc = c & 31, ob = rr * 64 + cc * 2; return st * 1024 + (ob ^ (((ob >> 9) & 1) << 5)); }
__host__ __device__ __forceinline__ void stage_rc(int b, int& R, int& C) { const int st = b / 1024, sb = b % 1024, swz = sb ^ (((sb >> 9) & 1) << 5); R = (st >> 1) * 16 + swz / 64; C = (st & 1) * 32 + (swz % 64) / 2; }
__host__ __device__ __forceinline__ int perm32(int rho) { const int n = rho >> 4, i = rho & 15; return 8 * (i >> 2) + 4 * n + (i & 3); }

struct Unit { int pm, pn; };
struct Gemm { const bf16_t* A; const bf16_t* Bt; int M, N, K; };

struct StaticOrder {
    int nM, nN, nwg, G, c;
    __host__ __device__ void init(int M, int N, int G_, int c_) { nM = M / BM; nN = N / BM; nwg = nM * nN; G = G_; c = c_; }
    __host__ __device__ bool next(int i, Unit& u) const {
        const long L = (long)i * G + c; if (L >= nwg) return false;
        int wgid = (int)L; { const int q = nwg / NXCD, r = nwg % NXCD, xcd = wgid % NXCD, off = wgid / NXCD; wgid = (xcd < r ? xcd * (q + 1) : r * (q + 1) + (xcd - r) * q) + off; }
        const int nig = WGM * nN, gid = wgid / nig, fm = gid * WGM, gsz = (nM - fm) < WGM ? (nM - fm) : WGM;
        u.pm = fm + ((wgid % nig) % gsz); u.pn = (wgid % nig) / gsz; return true;
    }
    __device__ __forceinline__ void a_ready(const Unit&) const {}
    __device__ __forceinline__ void done(const Unit&) const {}
};

__device__ __forceinline__ unsigned cvt_pk_bf16(float lo, float hi) { unsigned r; asm volatile("v_cvt_pk_bf16_f32 %0, %1, %2" : "=v"(r) : "v"(lo), "v"(hi)); return r; }
typedef float f32x2 __attribute__((ext_vector_type(2)));
__device__ __forceinline__ float bf2f(unsigned short h) { return __uint_as_float((unsigned)h << 16); }
__device__ __forceinline__ float gelu_tanh(float x) {
    const float z2 = 1.5957691216057308f * (x + 0.044715f * x * x * x);
    return x * __builtin_amdgcn_rcpf(1.0f + __builtin_amdgcn_exp2f(-1.4426950408889634f * z2)); }
__device__ __forceinline__ float sigmoidf_(float a) { return __builtin_amdgcn_rcpf(1.0f + __builtin_amdgcn_exp2f(-1.4426950408889634f * a)); }
__device__ __forceinline__ float rs_of(float ssq) { return __builtin_amdgcn_rsqf(ssq * (1.0f / 1024.0f) + 1e-6f); }
__device__ __forceinline__ float slab16_sum(const float* slab, int row) { const f32x4* p = (const f32x4*)(slab + (size_t)row * 16); const f32x4 a = p[0], b = p[1], c = p[2], d = p[3];
    return (((a[0] + a[1]) + (a[2] + a[3])) + ((b[0] + b[1]) + (b[2] + b[3]))) + (((c[0] + c[1]) + (c[2] + c[3])) + ((d[0] + d[1]) + (d[2] + d[3]))); }
#ifndef EPI_WT
#define EPI_WT 0
#endif
__device__ __forceinline__ void st16(void* p, const u32x4 v) {
#if EPI_WT
    asm volatile("global_store_dwordx4 %0, %1, off sc1\n\ts_nop 1" :: "v"(p), "v"(v) : "memory");
#else
    *(u32x4*)p = v;
#endif
}
__device__ __forceinline__ u32x4 pack8(const f32x4 v0, const f32x4 v1) { u32x4 w; w.x = cvt_pk_bf16(v0[0], v0[1]); w.y = cvt_pk_bf16(v0[2], v0[3]); w.z = cvt_pk_bf16(v1[0], v1[1]); w.w = cvt_pk_bf16(v1[2], v1[3]); return w; }

template <int ACT> struct EpiRowScale {
    static constexpr bool PERM = true, AFTER_DRAIN = false;
    bf16_t* O; int ldc; const PG8_LAS float* rsl; int dbg;
    __device__ __forceinline__ void operator()(const f32x4 (&acc)[2][2][4][2], const Unit& u, int wr, int wc, int fr, int fq) const {
        const int row0 = u.pm * BM + wr * 64 + fr, col0 = u.pn * BM + wc * 32 + 8 * fq;
#ifdef DBG_EPI_NOMATH
        if (dbg) { _Pragma("unroll") for (int ai = 0; ai < 2; ++ai) _Pragma("unroll") for (int bj = 0; bj < 2; ++bj) _Pragma("unroll") for (int m = 0; m < 4; ++m) _Pragma("unroll") for (int n = 0; n < 2; ++n) asm volatile("" :: "v"(acc[ai][bj][m][n])); return; }
#endif
#pragma unroll
        for (int ai = 0; ai < 2; ++ai)
#pragma unroll
            for (int m = 0; m < 4; ++m) { const int row = row0 + ai * HALF + m * 16; const float rsr = rsl[ai * HALF + wr * 64 + m * 16 + fr]; bf16_t* rowp = O + (size_t)row * ldc + col0;
#pragma unroll
                for (int bj = 0; bj < 2; ++bj) { f32x4 v0 = acc[ai][bj][m][0] * rsr, v1 = acc[ai][bj][m][1] * rsr;
#pragma unroll
                    for (int e = 0; e < 4; ++e) {
                        if (ACT == 1) { const float a = fmaxf(v0[e], 0.f), b = fmaxf(v1[e], 0.f); v0[e] = a * a; v1[e] = b * b; }
                        if (ACT == 2) { v0[e] = gelu_tanh(v0[e]); v1[e] = gelu_tanh(v1[e]); } }
                    const u32x4 pk_ = pack8(v0, v1);
#ifdef DBG_EPI_NOSTORE
                    if (dbg) { asm volatile("" :: "v"(pk_)); } else
#endif
                    st16(rowp + bj * HALF, pk_); } }
    }
};
struct EpiGmV {
    static constexpr bool PERM = true, AFTER_DRAIN = false;
    bf16_t* O; int ldc; const float* ssq; float* ssqv;
    __device__ __forceinline__ void operator()(const f32x4 (&acc)[2][2][4][2], const Unit& u, int wr, int wc, int fr, int fq) const {
        const int row0 = u.pm * BM + wr * 64 + fr, col0 = u.pn * BM + wc * 32 + 8 * fq;
        float rsv[2][8], part[2][8];
#pragma unroll
        for (int bj = 0; bj < 2; ++bj) { const f32x4 s0 = *(const f32x4*)(ssq + col0 + bj * HALF), s1 = *(const f32x4*)(ssq + col0 + bj * HALF + 4);
#pragma unroll
            for (int e = 0; e < 4; ++e) { rsv[bj][e] = rs_of(s0[e]); rsv[bj][4 + e] = rs_of(s1[e]); part[bj][e] = 0.f; part[bj][4 + e] = 0.f; } }
#pragma unroll
        for (int ai = 0; ai < 2; ++ai)
#pragma unroll
            for (int m = 0; m < 4; ++m) { const int row = row0 + ai * HALF + m * 16; bf16_t* rowp = O + (size_t)row * ldc + col0;
#pragma unroll
                for (int bj = 0; bj < 2; ++bj) { f32x4 v0, v1;
#pragma unroll
                    for (int e = 0; e < 4; ++e) { v0[e] = gelu_tanh(acc[ai][bj][m][0][e] * rsv[bj][e]); v1[e] = gelu_tanh(acc[ai][bj][m][1][e] * rsv[bj][4 + e]);
                        part[bj][e] += v0[e] * v0[e]; part[bj][4 + e] += v1[e] * v1[e]; }
                    st16(rowp + bj * HALF, pack8(v0, v1)); } }
#pragma unroll
        for (int bj = 0; bj < 2; ++bj)
#pragma unroll
            for (int e = 0; e < 8; ++e) { float p = part[bj][e]; p += __shfl_xor(p, 1); p += __shfl_xor(p, 2); p += __shfl_xor(p, 4); p += __shfl_xor(p, 8);
                if (fr == 0) ssqv[(size_t)(col0 + bj * HALF + e) * 24 + 2 * u.pm + wr] = p; }
    }
};
struct EpiGlu {
    static constexpr bool PERM = true, AFTER_DRAIN = false;
    bf16_t* O; const bf16_t* G; const float* bias;
    __device__ __forceinline__ void operator()(const f32x4 (&acc)[2][2][4][2], const Unit& u, int wr, int wc, int fr, int fq) const {
        const int row0 = u.pm * BM + wr * 64 + fr, col0 = u.pn * BM + wc * 32 + 8 * fq;
        u32x4 gw[2][4][2]; f32x4 bv[2][2];
#pragma unroll
        for (int ai = 0; ai < 2; ++ai)
#pragma unroll
            for (int m = 0; m < 4; ++m)
#pragma unroll
                for (int bj = 0; bj < 2; ++bj) gw[ai][m][bj] = *(const u32x4*)(G + (size_t)(row0 + ai * HALF + m * 16) * 1024 + col0 + bj * HALF);
#pragma unroll
        for (int bj = 0; bj < 2; ++bj) { bv[bj][0] = *(const f32x4*)(bias + col0 + bj * HALF); bv[bj][1] = *(const f32x4*)(bias + col0 + bj * HALF + 4); }
#pragma unroll
        for (int ai = 0; ai < 2; ++ai)
#pragma unroll
            for (int m = 0; m < 4; ++m) { const size_t off = (size_t)(row0 + ai * HALF + m * 16) * 1024 + col0;
#pragma unroll
                for (int bj = 0; bj < 2; ++bj) { const u32x4 w = gw[ai][m][bj]; f32x4 v0, v1;
#pragma unroll
                    for (int e = 0; e < 4; ++e) { const unsigned w0 = w[e >> 1], w1 = w[2 + (e >> 1)];
                        const float g0 = (e & 1) ? __uint_as_float(w0 & 0xffff0000u) : __uint_as_float(w0 << 16), g1 = (e & 1) ? __uint_as_float(w1 & 0xffff0000u) : __uint_as_float(w1 << 16);
                        v0[e] = g0 * sigmoidf_(acc[ai][bj][m][0][e] + bv[bj][0][e]); v1[e] = g1 * sigmoidf_(acc[ai][bj][m][1][e] + bv[bj][1][e]); }
                    st16(O + off + bj * HALF, pack8(v0, v1)); } }
    }
};
struct EpiRes {
    static constexpr bool PERM = true, AFTER_DRAIN = false;
    float* out; bf16_t* xb; float* ssq;
    __device__ __forceinline__ void operator()(const f32x4 (&acc)[2][2][4][2], const Unit& u, int wr, int wc, int fr, int fq) const {
        const int row0 = u.pm * BM + wr * 64 + fr, col0 = u.pn * BM + wc * 32 + 8 * fq;
        u32x4 bw[2][4][2];
#pragma unroll
        for (int ai = 0; ai < 2; ++ai)
#pragma unroll
            for (int m = 0; m < 4; ++m)
#pragma unroll
                for (int bj = 0; bj < 2; ++bj) bw[ai][m][bj] = *(const u32x4*)(xb + (size_t)(row0 + ai * HALF + m * 16) * 1024 + col0 + bj * HALF);
#pragma unroll
        for (int ai = 0; ai < 2; ++ai)
#pragma unroll
            for (int m = 0; m < 4; ++m) { const int row = row0 + ai * HALF + m * 16; const size_t off = (size_t)row * 1024 + col0; float ss = 0.f;
#pragma unroll
                for (int bj = 0; bj < 2; ++bj) { const u32x4 w = bw[ai][m][bj]; f32x4 o0, o1;
#pragma unroll
                    for (int e = 0; e < 4; ++e) { const unsigned w0 = w[e >> 1], w1 = w[2 + (e >> 1)];
                        o0[e] = ((e & 1) ? __uint_as_float(w0 & 0xffff0000u) : __uint_as_float(w0 << 16)) + acc[ai][bj][m][0][e];
                        o1[e] = ((e & 1) ? __uint_as_float(w1 & 0xffff0000u) : __uint_as_float(w1 << 16)) + acc[ai][bj][m][1][e]; }
                    if (out != nullptr) { *(f32x4*)(out + off + bj * HALF) = o0; *(f32x4*)(out + off + bj * HALF + 4) = o1; }
                    ss += (o0[0] * o0[0] + o0[1] * o0[1]) + (o0[2] * o0[2] + o0[3] * o0[3]) + (o1[0] * o1[0] + o1[1] * o1[1]) + (o1[2] * o1[2] + o1[3] * o1[3]);
                    if (out == nullptr) st16(xb + off + bj * HALF, pack8(o0, o1)); }
                ss += __shfl_xor(ss, 16); ss += __shfl_xor(ss, 32);
                if (ssq != nullptr && fq == 0) ssq[(size_t)row * 16 + 4 * u.pn + wc] = ss; }
    }
};
struct EpiQKV {
    static constexpr bool PERM = true, AFTER_DRAIN = false;
    bf16_t* Q; bf16_t* K; bf16_t* V; const PG8_LAS float* rsl; const PG8_LAS int* posl; const float* qg; const float* kg;
    __device__ __forceinline__ void operator()(const f32x4 (&acc)[2][2][4][2], const Unit& u, int wr, int wc, int fr, int fq) const {
        const int row0 = u.pm * BM + wr * 64 + fr, lrow0 = wr * 64 + fr; const int sect = u.pn >> 2, pnl = u.pn & 3; const int colb = pnl * 256 + wc * 64 + 8 * fq;
        if (sect == 2) {
#pragma unroll
            for (int ai = 0; ai < 2; ++ai)
#pragma unroll
                for (int m = 0; m < 4; ++m) { const int row = row0 + ai * HALF + m * 16; const float rsr = rsl[lrow0 + ai * HALF + m * 16]; bf16_t* rowp = V + (size_t)row * 1024 + colb;
#pragma unroll
                    for (int bj = 0; bj < 2; ++bj) st16(rowp + bj * 32, pack8(acc[ai][bj][m][0] * rsr, acc[ai][bj][m][1] * rsr)); }
        } else {
            const float* gn = sect == 0 ? qg : kg; bf16_t* dst = sect == 0 ? Q : K; const float osc = sect == 0 ? 0.125f * 1.4426950408889634f : 1.0f;
            float g[2][8], ifq[8];
#pragma unroll
            for (int bj = 0; bj < 2; ++bj) { const f32x4 a = *(const f32x4*)(gn + bj * 32 + 8 * fq), b = *(const f32x4*)(gn + bj * 32 + 8 * fq + 4);
#pragma unroll
                for (int e = 0; e < 4; ++e) { g[bj][e] = a[e]; g[bj][4 + e] = b[e]; } }
#pragma unroll
            for (int e = 0; e < 8; ++e) ifq[e] = __builtin_amdgcn_exp2f(-(float)(8 * fq + e) * 0.41524101186092029f);
#pragma unroll
            for (int ai = 0; ai < 2; ++ai)
#pragma unroll
                for (int m = 0; m < 4; ++m) { const int row = row0 + ai * HALF + m * 16, lrow = lrow0 + ai * HALF + m * 16; const float rsr = rsl[lrow]; const float posf = (float)posl[lrow];
                    float x[2][8]; float ss = 0.f;
#pragma unroll
                    for (int bj = 0; bj < 2; ++bj)
#pragma unroll
                        for (int e = 0; e < 8; ++e) { x[bj][e] = acc[ai][bj][m][e >> 2][e & 3] * rsr; ss += x[bj][e] * x[bj][e]; }
                    ss += __shfl_xor(ss, 16); ss += __shfl_xor(ss, 32);
                    const float r = __builtin_amdgcn_rsqf(ss * (1.0f / 64.0f) + 1e-6f) ;
                    f32x4 o1a, o1b, o2a, o2b;
#pragma unroll
                    for (int e = 0; e < 8; ++e) { const float ang = posf * ifq[e]; const float rev = __builtin_amdgcn_fractf(ang * 0.15915494309189533577f);
                        const float co = __builtin_amdgcn_cosf(rev), si = __builtin_amdgcn_sinf(rev);
                        const float x1 = x[0][e] * r * g[0][e], x2 = x[1][e] * r * g[1][e];
                        const float a = (x1 * co - x2 * si) * osc, b = (x2 * co + x1 * si) * osc;
                        if (e < 4) { o1a[e] = a; o2a[e] = b; } else { o1b[e - 4] = a; o2b[e - 4] = b; } }
                    bf16_t* rowp = dst + (size_t)row * 1024 + colb;
                    st16(rowp, pack8(o1a, o1b)); st16(rowp + 32, pack8(o2a, o2b)); }
        }
    }
};

template <class Epi, class Sched, bool ALIGN_EPI = false, bool SP2 = false>
__device__ __forceinline__ void gemm_phase(PG8_LAS unsigned char* lds, const Gemm g, const Sched& S, const Epi& E) {
    const int tid = tid_fresh(), wid = __builtin_amdgcn_readfirstlane(tid >> 6), lane = tid & 63, wr = wid >> 2, wc = wid & 3, fr = lane & 15, fq = lane >> 4;
    const int K = g.K, nt = K / BK;
    unsigned voffA[2], voffB[2];
#pragma unroll
    for (int i = 0; i < 2; ++i) { int R, C; stage_rc(tid * 16 + i * 8192, R, C); const int Rb = Epi::PERM ? ((R & ~31) + perm32(R & 31)) : R;
        voffA[i] = (unsigned)(R * K + C) * 2u; voffB[i] = (unsigned)(Rb * K + C) * 2u; }
    const size_t kstep = (size_t)(BK * 2);
    const size_t hstep = (size_t)HALF * K * 2;
    const size_t tstep = 2 * hstep;
    const unsigned ldsw = (unsigned)wid * 1024u;
    const int aoff = lds_byte(wr * 64 + fr, fq * 8), boff = lds_byte(wc * 32 + fr, fq * 8);
#define PG8_SA(b, h) (((b) * 2 + (h)) * HTB)
#define PG8_SB(b, h) ((4 + (b) * 2 + (h)) * HTB)
#define PG8_STAGE(bufoff, gbase, voff) do { _Pragma("unroll") for (int _i = 0; _i < 2; ++_i) \
        __builtin_amdgcn_global_load_lds((const unsigned*)((const char*)(gbase) + (voff)[_i]), (PG8_LAS unsigned*)(lds + (bufoff) + ldsw + _i * 8192), 16, 0, 0); } while (0)
#define PG8_LDA(dst, b, h) do { _Pragma("unroll") for (int m = 0; m < 4; ++m) _Pragma("unroll") for (int k = 0; k < 2; ++k) dst[m][k] = *(const PG8_LAS bf16x8*)(lds + PG8_SA(b, h) + aoff + m * 2048 + k * 1024); } while (0)
#define PG8_LDB(dst, b, h) do { _Pragma("unroll") for (int n = 0; n < 2; ++n) _Pragma("unroll") for (int k = 0; k < 2; ++k) dst[n][k] = *(const PG8_LAS bf16x8*)(lds + PG8_SB(b, h) + boff + n * 2048 + k * 1024); } while (0)
#define PG8_MMA(ai, bj, At, Bt) do { __builtin_amdgcn_s_setprio(1); _Pragma("unroll") for (int m = 0; m < 4; ++m) _Pragma("unroll") for (int n = 0; n < 2; ++n) _Pragma("unroll") for (int k = 0; k < 2; ++k) \
        acc[ai][bj][m][n] = __builtin_amdgcn_mfma_f32_16x16x32_bf16(Bt[n][k], At[m][k], acc[ai][bj][m][n], 0, 0, 0); __builtin_amdgcn_s_setprio(0); } while (0)
#define PG8_WAIT_V(n) asm volatile("s_waitcnt vmcnt(" #n ")" ::: "memory")
#define PG8_WAIT_L(n) asm volatile("s_waitcnt lgkmcnt(" #n ")" ::: "memory")
#define PG8_BAR __builtin_amdgcn_s_barrier()
#define PG8_SCHED __builtin_amdgcn_sched_barrier(0)
    Unit cur, nxt; int ui = 0;
    if (!S.next(0, cur)) return;
    f32x4 acc[2][2][4][2];
#pragma unroll
    for (int a = 0; a < 2; ++a)
#pragma unroll
        for (int b = 0; b < 2; ++b)
#pragma unroll
            for (int m = 0; m < 4; ++m)
#pragma unroll
                for (int n = 0; n < 2; ++n) acc[a][b][m][n] = (f32x4){0.f, 0.f, 0.f, 0.f};
    bf16x8 At[4][2], B0[2][2], B1[2][2];
    const char* cA = (const char*)g.A + (size_t)cur.pm * tstep; const char* cB = (const char*)g.Bt + (size_t)cur.pn * tstep;
    S.a_ready(cur);
    if constexpr (SP2) {
        PG8_STAGE(PG8_SB(0, 0), cB, voffB); PG8_STAGE(PG8_SB(0, 1), cB + hstep, voffB); PG8_STAGE(PG8_SA(0, 0), cA, voffA); PG8_STAGE(PG8_SA(0, 1), cA + hstep, voffA);
        if (wr == 1) PG8_BAR;
        PG8_WAIT_V(2); PG8_BAR;
        PG8_STAGE(PG8_SB(1, 0), cB + kstep, voffB); PG8_STAGE(PG8_SA(1, 0), cA + kstep, voffA); PG8_STAGE(PG8_SB(1, 1), cB + hstep + kstep, voffB);
        PG8_WAIT_V(6); PG8_BAR;
    } else {
        PG8_STAGE(PG8_SB(0, 0), cB, voffB); PG8_STAGE(PG8_SA(0, 0), cA, voffA); PG8_STAGE(PG8_SB(0, 1), cB + hstep, voffB); PG8_STAGE(PG8_SA(0, 1), cA + hstep, voffA);
        if (wr == 1) PG8_BAR;
        PG8_WAIT_V(4); PG8_BAR;
        PG8_STAGE(PG8_SB(1, 0), cB + kstep, voffB); PG8_STAGE(PG8_SA(1, 0), cA + kstep, voffA); PG8_STAGE(PG8_SB(1, 1), cB + hstep + kstep, voffB);
        PG8_WAIT_V(6); PG8_BAR;
    }
    for (;;) {
        const bool has_next = S.next(ui + 1, nxt);
        const char* nA = has_next ? (const char*)g.A + (size_t)nxt.pm * tstep : cA; const char* nB = has_next ? (const char*)g.Bt + (size_t)nxt.pn * tstep : cB;
        for (int t = 0; t < nt; t += 2) {
            const bool last = (t == nt - 2);
            const char* a1 = cA + (size_t)(t + 1) * kstep;
            const char* a2 = last ? nA : cA + (size_t)(t + 2) * kstep; const char* b2 = last ? nB : cB + (size_t)(t + 2) * kstep;
            const char* a3 = a2 + kstep; const char* b3 = b2 + kstep;
            if (last && has_next) S.a_ready(nxt);
            if constexpr (SP2) {
            PG8_LDB(B0, 0, 0); PG8_LDB(B1, 0, 1); PG8_SCHED; PG8_LDA(At, 0, 0); PG8_STAGE(PG8_SA(1, 1), a1 + hstep, voffA);
            PG8_WAIT_V(8); PG8_WAIT_L(0); PG8_BAR; PG8_MMA(0, 0, At, B0); PG8_MMA(0, 1, At, B1); PG8_BAR; PG8_SCHED;
            PG8_LDA(At, 0, 1); PG8_STAGE(PG8_SB(0, 0), b2, voffB); PG8_STAGE(PG8_SB(0, 1), b2 + hstep, voffB); PG8_STAGE(PG8_SA(0, 0), a2, voffA);
            PG8_WAIT_V(8); PG8_WAIT_L(0); PG8_BAR; PG8_MMA(1, 0, At, B0); PG8_MMA(1, 1, At, B1); PG8_BAR; PG8_SCHED;
            PG8_LDB(B0, 1, 0); PG8_LDB(B1, 1, 1); PG8_SCHED; PG8_LDA(At, 1, 0); PG8_STAGE(PG8_SA(0, 1), a2 + hstep, voffA);
            PG8_WAIT_V(8); PG8_WAIT_L(0); PG8_BAR; PG8_MMA(0, 0, At, B0); PG8_MMA(0, 1, At, B1); PG8_BAR; PG8_SCHED;
            PG8_LDA(At, 1, 1); PG8_STAGE(PG8_SB(1, 0), b3, voffB); PG8_STAGE(PG8_SB(1, 1), b3 + hstep, voffB); PG8_STAGE(PG8_SA(1, 0), a3, voffA);
            PG8_WAIT_V(8); PG8_WAIT_L(0); PG8_BAR; PG8_MMA(1, 0, At, B0); PG8_MMA(1, 1, At, B1); PG8_BAR; PG8_SCHED;
            } else {
            PG8_LDB(B0, 0, 0); PG8_SCHED; PG8_LDA(At, 0, 0); PG8_STAGE(PG8_SA(1, 1), a1 + hstep, voffA);
            PG8_WAIT_L(8); PG8_BAR; PG8_WAIT_L(0); PG8_MMA(0, 0, At, B0); PG8_BAR; PG8_SCHED;
            PG8_LDB(B1, 0, 1); PG8_STAGE(PG8_SB(0, 0), b2, voffB);
            PG8_BAR; PG8_WAIT_L(0); PG8_MMA(0, 1, At, B1); PG8_BAR;
            PG8_LDA(At, 0, 1); PG8_STAGE(PG8_SA(0, 0), a2, voffA);
            PG8_BAR; PG8_WAIT_L(0); PG8_MMA(1, 0, At, B0); PG8_BAR; PG8_SCHED;
            PG8_STAGE(PG8_SB(0, 1), b2 + hstep, voffB);
            PG8_WAIT_V(6); PG8_BAR; PG8_MMA(1, 1, At, B1); PG8_BAR;
            PG8_LDB(B0, 1, 0); PG8_SCHED; PG8_LDA(At, 1, 0); PG8_STAGE(PG8_SA(0, 1), a2 + hstep, voffA);
            PG8_WAIT_L(8); PG8_BAR; PG8_WAIT_L(0); PG8_MMA(0, 0, At, B0); PG8_BAR; PG8_SCHED;
            PG8_LDB(B1, 1, 1); PG8_STAGE(PG8_SB(1, 0), b3, voffB);
            PG8_BAR; PG8_WAIT_L(0); PG8_MMA(0, 1, At, B1); PG8_BAR;
            PG8_LDA(At, 1, 1); PG8_STAGE(PG8_SA(1, 0), a3, voffA);
            PG8_BAR; PG8_WAIT_L(0); PG8_MMA(1, 0, At, B0); PG8_BAR; PG8_SCHED;
            PG8_STAGE(PG8_SB(1, 1), b3 + hstep, voffB);
            PG8_WAIT_V(6); PG8_BAR; PG8_MMA(1, 1, At, B1); PG8_BAR;
            }
        }
        if constexpr (ALIGN_EPI) { if (wr == 0) PG8_BAR; }
        if constexpr (!Epi::AFTER_DRAIN) { E(acc, cur, wr, wc, fr, fq); S.done(cur); }
        if (!has_next) break;
#pragma unroll
        for (int a = 0; a < 2; ++a)
#pragma unroll
            for (int b = 0; b < 2; ++b)
#pragma unroll
                for (int m = 0; m < 4; ++m)
#pragma unroll
                    for (int n = 0; n < 2; ++n) acc[a][b][m][n] = (f32x4){0.f, 0.f, 0.f, 0.f};
        cur = nxt; cA = nA; cB = nB; ++ui;
        if constexpr (ALIGN_EPI) { if (wr == 1) PG8_BAR; }
    }
    PG8_WAIT_V(0);
    if constexpr (!ALIGN_EPI) { if (wr == 0) PG8_BAR; }
    PG8_BAR;
    if constexpr (Epi::AFTER_DRAIN) { E.fused(acc, cur, wr, wc, fr, fq, lds, wid, lane); S.done(cur); }
#undef PG8_SA
#undef PG8_SB
#undef PG8_STAGE
#undef PG8_LDA
#undef PG8_LDB
#undef PG8_MMA
#undef PG8_WAIT_V
#undef PG8_WAIT_L
#undef PG8_BAR
#undef PG8_SCHED
}
}
#ifndef PG8_SP2
#define PG8_SP2 true
#endif
#include <hip/hip_bf16.h>
#include <cmath>
namespace attn_body {
using bf16=__hip_bfloat16;
using bf16x8=__attribute__((ext_vector_type(8)))short;
using s16x4=__attribute__((ext_vector_type(4)))short;
using f32x16=__attribute__((ext_vector_type(16)))float;
using u32x4=__attribute__((ext_vector_type(4)))unsigned;
constexpr int BATCH=4,NHEAD=16,SEQ=4096,D=64,DM=NHEAD*D;
constexpr int NW=8,QBLK=32,QB=QBLK*NW,KVBLK=64,NQB=SEQ/QB;
constexpr int ATTN_PITCH=DM, ATTN_UNIT_ROWS=QB;
__device__ __forceinline__ int crow(int r,int hi){return (r&3)+8*(r>>2)+4*hi;}
#define SBAR() __builtin_amdgcn_sched_barrier(0)
__device__ __forceinline__ void cmask(f32x16&p0,f32x16&p1,int jb,int qrel,int hi){
  const float NEG=-INFINITY; int kb=64*jb+4*hi;
  #pragma unroll
  for(int r=0;r<16;++r){int kv=kb+(r&3)+8*(r>>2); if(kv>qrel)p0[r]=NEG; if(kv+32>qrel)p1[r]=NEG;}
}

constexpr int NSLOT=3, SLOTB=8192;
constexpr int LDS_K=0, LDS_V=NSLOT*SLOTB, LDS_WS=LDS_V+NSLOT*2*SLOTB, LDS_OST=LDS_WS+NW*64*4, LDS_BYTES=LDS_OST+NW*4096;
constexpr float C2=0.125f*1.4426950408889634f;
__device__ __forceinline__ void glds16(const void*gsrc,unsigned lds_dst){unsigned keep;
  asm volatile("s_mov_b32 %0, m0\n\ts_mov_b32 m0, %2\n\ts_nop 0\n\tglobal_load_lds_dwordx4 %1, off\n\ts_mov_b32 m0, %0":"=&s"(keep):"v"(gsrc),"s"(lds_dst):"memory");}
__device__ __forceinline__ float max3f(float a,float b,float c){float r;asm("v_max3_f32 %0, %1, %2, %3":"=v"(r):"v"(a),"v"(b),"v"(c));return r;}
__device__ __forceinline__ float max2f(float a,float b){float r;asm("v_max_f32_e32 %0, %1, %2":"=v"(r):"v"(a),"v"(b));return r;}
__device__ __forceinline__ float fadd_s(float a,float b){float r;asm("v_add_f32_e32 %0, %1, %2":"=v"(r):"v"(a),"v"(b));return r;}
__device__ __forceinline__ float fsub_s(float a,float b){float r;asm("v_sub_f32_e32 %0, %1, %2":"=v"(r):"v"(a),"v"(b));return r;}
typedef float f32x2_t __attribute__((ext_vector_type(2))); typedef __bf16 bf16x2_t __attribute__((ext_vector_type(2)));
__device__ __forceinline__ unsigned cvtpk_s(float lo,float hi){f32x2_t v={lo,hi};bf16x2_t b=__builtin_convertvector(v,bf16x2_t);return __builtin_bit_cast(unsigned,b);}
#define WAIT_BAR(N) asm volatile("s_waitcnt vmcnt(" #N ") lgkmcnt(0)\n\ts_barrier":::"memory")

__device__ __forceinline__ void qkt(f32x16&p0,f32x16&p1,const char*Kslot,const bf16x8*qr,int r32,int hi){ const f32x16 negm=f32x16{};
  const char*kb=Kslot+hi*1024+r32*16;
  #pragma unroll
  for(int d0=0;d0<4;++d0){
    const bf16x8 b0=*reinterpret_cast<const bf16x8*>(kb+d0*2048);
    const bf16x8 b1=*reinterpret_cast<const bf16x8*>(kb+d0*2048+512);
    if(d0==0){p0=__builtin_amdgcn_mfma_f32_32x32x16_bf16(b0,qr[0],negm,0,0,0);p1=__builtin_amdgcn_mfma_f32_32x32x16_bf16(b1,qr[0],negm,0,0,0);}
    else{p0=__builtin_amdgcn_mfma_f32_32x32x16_bf16(b0,qr[d0],p0,0,0,0);p1=__builtin_amdgcn_mfma_f32_32x32x16_bf16(b1,qr[d0],p1,0,0,0);}}
}
typedef __attribute__((address_space(3))) const char* lds_cptr;
typedef short v4i16_t __attribute__((ext_vector_type(4)));
__device__ __forceinline__ void kload8(bf16x8*kf,lds_cptr kp){
  kf[0]=*(const __attribute__((address_space(3))) bf16x8*)(kp);      kf[1]=*(const __attribute__((address_space(3))) bf16x8*)(kp+512);
  kf[2]=*(const __attribute__((address_space(3))) bf16x8*)(kp+2048); kf[3]=*(const __attribute__((address_space(3))) bf16x8*)(kp+2560);
  kf[4]=*(const __attribute__((address_space(3))) bf16x8*)(kp+4096); kf[5]=*(const __attribute__((address_space(3))) bf16x8*)(kp+4608);
  kf[6]=*(const __attribute__((address_space(3))) bf16x8*)(kp+6144); kf[7]=*(const __attribute__((address_space(3))) bf16x8*)(kp+6656);
}
__device__ __forceinline__ void kload2(bf16x8*kf,lds_cptr kp,int j){ kf[2*j]=*(const __attribute__((address_space(3))) bf16x8*)(kp+j*2048); kf[2*j+1]=*(const __attribute__((address_space(3))) bf16x8*)(kp+j*2048+512); }
__device__ __forceinline__ s16x4 vtr(lds_cptr p){ return __builtin_bit_cast(s16x4,__builtin_amdgcn_ds_read_tr16_b64_v4i16((__attribute__((address_space(3))) v4i16_t*)p)); }
__device__ __forceinline__ float rowmax(const f32x16&p0,const f32x16&p1){
  float a=max3f(p0[0],p0[1],p1[0]),b=max3f(p0[2],p0[3],p1[1]);a=max3f(a,p1[2],p1[3]);
  #pragma unroll
  for(int r=4;r<16;r+=4){a=max3f(a,p0[r],p0[r+1]);b=max3f(b,p0[r+2],p0[r+3]);a=max3f(a,p1[r],p1[r+1]);b=max3f(b,p1[r+2],p1[r+3]);}
  const float m=max2f(a,b);
  auto rr=__builtin_amdgcn_permlane32_swap(__float_as_uint(m),__float_as_uint(m),false,false);
  return max2f(__uint_as_float(rr[0]),__uint_as_float(rr[1]));
}
__device__ __forceinline__ void pv(f32x16*o,int vb,bf16x8 pa0,bf16x8 pa1,bf16x8 pa2,bf16x8 pa3){
  #pragma unroll
  for(int d0=0;d0<4;++d0){s16x4 lo[4],hi[4];
    #pragma unroll
    for(int ks=0;ks<4;++ks){
      asm volatile("ds_read_b64_tr_b16 %0,%1 offset:%c2":"=&v"(lo[ks]):"v"(vb),"i"(d0*4096+ks*1024):"memory");
      asm volatile("ds_read_b64_tr_b16 %0,%1 offset:%c2":"=&v"(hi[ks]):"v"(vb),"i"(d0*4096+ks*1024+512):"memory");}
    asm volatile("s_waitcnt lgkmcnt(0)":::"memory");SBAR();
    #define PK(k) (bf16x8){lo[k][0],lo[k][1],lo[k][2],lo[k][3],hi[k][0],hi[k][1],hi[k][2],hi[k][3]}
    o[d0]=__builtin_amdgcn_mfma_f32_32x32x16_bf16(pa0,PK(0),o[d0],0,0,0);
    o[d0]=__builtin_amdgcn_mfma_f32_32x32x16_bf16(pa1,PK(1),o[d0],0,0,0);
    o[d0]=__builtin_amdgcn_mfma_f32_32x32x16_bf16(pa2,PK(2),o[d0],0,0,0);
    o[d0]=__builtin_amdgcn_mfma_f32_32x32x16_bf16(pa3,PK(3),o[d0],0,0,0);
    #undef PK
  }
}

#ifndef ATTN_STORE16
#define ATTN_STORE16(p,v) (*(u32x4*)(p)=(v))
#endif
template<int THRL> __device__ __forceinline__ void attn_unit(int b,int colQK,int colV,int qb,const bf16*Q,const bf16*__restrict__ K,const bf16*__restrict__ V,bf16*O,char*shm,const float sh){
  const int tid=tid_fresh(),lane=tid&63,r32=lane&31,hi=lane>>5; const int wid=__builtin_amdgcn_readfirstlane(tid>>6);
  const long rowbase=(long)b*SEQ; const int q0=qb*QB;
  const bf16*Qw=Q+(rowbase+q0+wid*QBLK)*DM+colQK;
  const bf16*Kh=K+rowbase*DM+colQK,*Vh=V+rowbase*DM+colV;
  const unsigned lds0=(unsigned)(uintptr_t)shm;
  float*wsf=(float*)(shm+LDS_WS)+wid*64;
  const bf16*ksrc=Kh+(long)lane*DM+wid*8;
  const bf16*vsrc=Vh+(long)(16*(wid&3)+(lane>>2))*DM+(wid>>2)*32+(lane&3)*8;
  const unsigned kdst=lds0+LDS_K+wid*1024, vdst=lds0+LDS_V+wid*1024;
  #define DMA_K(t,slot) glds16(ksrc+(long)(t)*KVBLK*DM,(unsigned)__builtin_amdgcn_readfirstlane(kdst+(slot)))
  #define DMA_V(t,slot) do{ glds16(vsrc+(long)(t)*KVBLK*DM,(unsigned)__builtin_amdgcn_readfirstlane(vdst+2*(slot))); glds16(vsrc+(long)(t)*KVBLK*DM+64,(unsigned)__builtin_amdgcn_readfirstlane(vdst+2*(slot)+8192)); }while(0)
  const int vb0=(int)(lds0+LDS_V)+((lane>>4)&1)*32+(lane&3)*8+(4*hi+((lane&15)>>2))*64;
  const char*Kbase=shm+LDS_K; bf16x8 kf[8];
  const lds_cptr shm3=(lds_cptr)shm; const lds_cptr kp0=shm3+LDS_K+hi*1024+r32*16; const lds_cptr vp0=shm3+LDS_V+((lane>>4)&1)*32+(lane&3)*8+(4*hi+((lane&15)>>2))*64;
  const int NT=(q0+QB)/KVBLK;
  DMA_K(0,0);DMA_V(0,0);DMA_K(1,SLOTB);
  bf16x8 qr[4];
  #pragma unroll
  for(int d0=0;d0<4;++d0)qr[d0]=*reinterpret_cast<const bf16x8*>(&Qw[(long)r32*DM+d0*16+hi*8]);
  float l_reg=0.f;f32x16 o[4];o[0]=f32x16{};o[1]=f32x16{};o[2]=f32x16{};o[3]=f32x16{};const f32x16 zero16=f32x16{};
  const int qrel=wid*QBLK+r32;
  #define CMASK(P0,P1,t) do{int jb_=(t)-(NT-4); if(jb_>=0)cmask(P0,P1,jb_,qrel,hi);}while(0)
  const bool shon=__builtin_amdgcn_readfirstlane(sh>0.f?1:0)!=0;
  #define START(P0,P1) do{ if(shon){ _Pragma("unroll") for(int r=0;r<16;++r){P0[r]=fsub_s(P0[r],sh);P1[r]=fsub_s(P1[r],sh);} } \
    _Pragma("unroll") for(int r=0;r<16;++r)P0[r]=__builtin_amdgcn_exp2f(P0[r]); }while(0)
  #define RESC() do{}while(0)
  f32x16 pA0,pA1,pB0,pB1;
  int sl_prev=0,sl_cur=0,sl_next=SLOTB;
  #define ROT() do{sl_prev=sl_cur;sl_cur=sl_next;sl_next=(sl_next==(NSLOT-1)*SLOTB)?0:sl_next+SLOTB;}while(0)
  DMA_K(2,2*SLOTB);
  WAIT_BAR(4);
  qkt(pA0,pA1,Kbase,qr,r32,hi);asm volatile("s_nop 15\n\ts_nop 7":"+v"(pA0),"+v"(pA1));CMASK(pA0,pA1,0);
  START(pA0,pA1);
  _Pragma("unroll") for(int r=0;r<16;++r)pA1[r]=__builtin_amdgcn_exp2f(pA1[r]);
  WAIT_BAR(0);
  DMA_K(3,0);DMA_V(1,SLOTB);
  ROT();
  kload8(kf,kp0+sl_cur);
  WAIT_BAR(3);
  s16x4 vlo[8],vhi[8]; u32x4 pw0,pw1,pw2,pw3;
  #define PKW(P,B) cvtpk_s(P[B],P[B+1])
  #define PAF(k) __builtin_bit_cast(bf16x8,pw##k)
  #define VFR(i) (bf16x8){vlo[i][0],vlo[i][1],vlo[i][2],vlo[i][3],vhi[i][0],vhi[i][1],vhi[i][2],vhi[i][3]}
  #define PIN(x) asm volatile("":"+v"(x))
  #define MX3(a,b,c) __builtin_fmaxf(__builtin_fmaxf((a),(b)),(c))
  #define GAPA(MF,A0,A1,A2,A3,W0,W1,PW) do{ MF; sacc+=A0; sacc+=A1; sacc+=A2; sacc+=A3; PIN(sacc); W0; W1; PIN(PW); SBAR(); }while(0)
  #define EX(v) __builtin_amdgcn_exp2f(v)
  #define GAPB(MF,X,B) do{ MF; X[B]=EX(X[B]); X[B+1]=EX(X[B+1]); PIN(X); SBAR(); }while(0)
  #define VRD(i) do{ vlo[i]=vtr(vp_+(((i)>>2)*4096+((i)&3)*1024)); vhi[i]=vtr(vp_+(((i)>>2)*4096+((i)&3)*1024+512)); }while(0)
  #define VRD2(i) do{ vlo[i]=vtr(vp_+(8192+((i)>>2)*4096+((i)&3)*1024)); vhi[i]=vtr(vp_+(8192+((i)>>2)*4096+((i)&3)*1024+512)); SBAR(); }while(0)
  #define KRD(G,j) do{ if(G){ kload2(kf,kp0+sl_next,j); SBAR(); } }while(0)
  #define STEP(C0,C1,P0,P1,t,GK,GV,GL) do{ SBAR(); \
    const lds_cptr vp_=vp0+2*sl_prev; \
    VRD(0); SBAR(); float sacc=(P0[0]+P0[1]); \
    GAPA(C0=__builtin_amdgcn_mfma_f32_32x32x16_bf16(kf[0],qr[0],zero16,0,0,0), P0[2],P0[3],P0[4],P0[5],     pw0[0]=PKW(P0,0), pw0[1]=PKW(P0,2), pw0); \
    VRD(4); SBAR(); GAPA(C1=__builtin_amdgcn_mfma_f32_32x32x16_bf16(kf[1],qr[0],zero16,0,0,0), P0[6],P0[7],P0[8],P0[9],     pw0[2]=PKW(P0,4), pw0[3]=PKW(P0,6), pw0); \
    VRD(1); SBAR(); GAPA(C0=__builtin_amdgcn_mfma_f32_32x32x16_bf16(kf[2],qr[1],C0,0,0,0),   P0[10],P0[11],P0[12],P0[13], pw1[0]=PKW(P0,8), pw1[1]=PKW(P0,10), pw1); \
    VRD(5); SBAR(); GAPA(C1=__builtin_amdgcn_mfma_f32_32x32x16_bf16(kf[3],qr[1],C1,0,0,0),   P0[14],P0[15],P1[0],P1[1],   pw1[2]=PKW(P0,12),pw1[3]=PKW(P0,14), pw1); \
    VRD(2); SBAR(); GAPA(C0=__builtin_amdgcn_mfma_f32_32x32x16_bf16(kf[4],qr[2],C0,0,0,0),   P1[2],P1[3],P1[4],P1[5],     pw2[0]=PKW(P1,0), pw2[1]=PKW(P1,2), pw2); \
    VRD(6); SBAR(); GAPA(C1=__builtin_amdgcn_mfma_f32_32x32x16_bf16(kf[5],qr[2],C1,0,0,0),   P1[6],P1[7],P1[8],P1[9],     pw2[2]=PKW(P1,4), pw2[3]=PKW(P1,6), pw2); \
    VRD(3); SBAR(); GAPA(C0=__builtin_amdgcn_mfma_f32_32x32x16_bf16(kf[6],qr[3],C0,0,0,0),   P1[10],P1[11],P1[12],P1[13], pw3[0]=PKW(P1,8), pw3[1]=PKW(P1,10), pw3); \
    VRD(7); SBAR(); GAPA(C1=__builtin_amdgcn_mfma_f32_32x32x16_bf16(kf[7],qr[3],C1,0,0,0),   P1[14],P1[15],0.f,0.f,       pw3[2]=PKW(P1,12),pw3[3]=PKW(P1,14), pw3); \
    l_reg+=sacc; \
    if(GK){DMA_K((t)+3,sl_cur);} if(GV){DMA_V((t)+1,sl_next);} \
    CMASK(C0,C1,t); \
    if(shon){ _Pragma("unroll") for(int r=0;r<16;++r){C0[r]-=sh;C1[r]-=sh;} } \
    SBAR(); \
    GAPB(o[0]=__builtin_amdgcn_mfma_f32_32x32x16_bf16(PAF(0),VFR(0),o[0],0,0,0), C0,0);  VRD2(0); \
    GAPB(o[1]=__builtin_amdgcn_mfma_f32_32x32x16_bf16(PAF(0),VFR(4),o[1],0,0,0), C0,2);  VRD2(4); \
    KRD(GL,0); GAPB(o[0]=__builtin_amdgcn_mfma_f32_32x32x16_bf16(PAF(1),VFR(1),o[0],0,0,0), C0,4);  VRD2(1); \
    KRD(GL,1); GAPB(o[1]=__builtin_amdgcn_mfma_f32_32x32x16_bf16(PAF(1),VFR(5),o[1],0,0,0), C0,6);  VRD2(5); \
    KRD(GL,2); GAPB(o[0]=__builtin_amdgcn_mfma_f32_32x32x16_bf16(PAF(2),VFR(2),o[0],0,0,0), C0,8);  VRD2(2); \
    KRD(GL,3); GAPB(o[1]=__builtin_amdgcn_mfma_f32_32x32x16_bf16(PAF(2),VFR(6),o[1],0,0,0), C0,10); VRD2(6); \
    GAPB(o[0]=__builtin_amdgcn_mfma_f32_32x32x16_bf16(PAF(3),VFR(3),o[0],0,0,0), C0,12); VRD2(3); \
    GAPB(o[1]=__builtin_amdgcn_mfma_f32_32x32x16_bf16(PAF(3),VFR(7),o[1],0,0,0), C0,14); VRD2(7); \
    GAPB(o[2]=__builtin_amdgcn_mfma_f32_32x32x16_bf16(PAF(0),VFR(0),o[2],0,0,0), C1,0); \
    GAPB(o[3]=__builtin_amdgcn_mfma_f32_32x32x16_bf16(PAF(0),VFR(4),o[3],0,0,0), C1,2); \
    GAPB(o[2]=__builtin_amdgcn_mfma_f32_32x32x16_bf16(PAF(1),VFR(1),o[2],0,0,0), C1,4); \
    GAPB(o[3]=__builtin_amdgcn_mfma_f32_32x32x16_bf16(PAF(1),VFR(5),o[3],0,0,0), C1,6); \
    GAPB(o[2]=__builtin_amdgcn_mfma_f32_32x32x16_bf16(PAF(2),VFR(2),o[2],0,0,0), C1,8); \
    GAPB(o[3]=__builtin_amdgcn_mfma_f32_32x32x16_bf16(PAF(2),VFR(6),o[3],0,0,0), C1,10); \
    GAPB(o[2]=__builtin_amdgcn_mfma_f32_32x32x16_bf16(PAF(3),VFR(3),o[2],0,0,0), C1,12); \
    GAPB(o[3]=__builtin_amdgcn_mfma_f32_32x32x16_bf16(PAF(3),VFR(7),o[3],0,0,0), C1,14); \
    }while(0)
  int t=1;
  #undef CMASK
  #define CMASK(P0,P1,t) do{}while(0)
  for(;t+5<NT;t+=2){
    STEP(pB0,pB1,pA0,pA1,t,true,true,true);     WAIT_BAR(3); RESC(); ROT();
    STEP(pA0,pA1,pB0,pB1,t+1,true,true,true);   WAIT_BAR(3); RESC(); ROT();
  }
  #undef CMASK
  #define CMASK(P0,P1,t) do{int jb_=(t)-(NT-4); if(jb_>=0)cmask(P0,P1,jb_,qrel,hi);}while(0)
  #define ENDW(tt) do{ if((tt)+3<NT){WAIT_BAR(3);} else if((tt)+2<NT){WAIT_BAR(2);} else {WAIT_BAR(0);} }while(0)
  for(;t+1<NT;t+=2){
    STEP(pB0,pB1,pA0,pA1,t,(t+3<NT),(t+1<NT),(t+1<NT));       ENDW(t);   RESC(); ROT();
    STEP(pA0,pA1,pB0,pB1,t+1,(t+4<NT),(t+2<NT),(t+2<NT));     ENDW(t+1); RESC(); ROT();
  }
  STEP(pB0,pB1,pA0,pA1,NT-1,false,false,false); RESC();
  { float sacc=pB0[0]+pB0[1]; _Pragma("unroll") for(int r=2;r<16;++r)sacc+=pB0[r]; _Pragma("unroll") for(int r=0;r<16;++r)sacc+=pB1[r]; l_reg+=sacc;
    pw0=(u32x4){PKW(pB0,0),PKW(pB0,2),PKW(pB0,4),PKW(pB0,6)};pw1=(u32x4){PKW(pB0,8),PKW(pB0,10),PKW(pB0,12),PKW(pB0,14)};pw2=(u32x4){PKW(pB1,0),PKW(pB1,2),PKW(pB1,4),PKW(pB1,6)};pw3=(u32x4){PKW(pB1,8),PKW(pB1,10),PKW(pB1,12),PKW(pB1,14)};
    SBAR(); pv(o,vb0+2*sl_cur,PAF(0),PAF(1),PAF(2),PAF(3)); }
  #undef PKW
  #undef PAF
  #undef VFR
  #undef PIN
  #undef MX3
  #undef GAPA
  #undef GAPB
  #undef EX
  #undef VRD
  #undef VRD2
  #undef KRD
  #undef STEP
  #undef ENDW
  {auto rr=__builtin_amdgcn_permlane32_swap(__float_as_uint(l_reg),__float_as_uint(l_reg),false,false);l_reg=__uint_as_float(rr[0])+__uint_as_float(rr[1]);}
  if(hi==0)wsf[32+r32]=l_reg;asm volatile("s_waitcnt lgkmcnt(0)":::"memory");
  float rli[16];
  #pragma unroll
  for(int r=0;r<16;++r)rli[r]=__builtin_amdgcn_rcpf(wsf[32+crow(r,hi)]);
  bf16*Ow=O+(rowbase+q0+wid*QBLK)*DM+colV;
  { bf16*stg=(bf16*)(shm+LDS_OST)+wid*2048;
    #pragma unroll
    for(int hf=0;hf<2;++hf){
      #pragma unroll
      for(int r=0;r<16;++r){const int orow=crow(r,hi);
        #pragma unroll
        for(int d0=0;d0<2;++d0)stg[orow*64+d0*32+r32]=__float2bfloat16(o[2*hf+d0][r]*rli[r]);}
      asm volatile("s_waitcnt lgkmcnt(0)":::"memory");
      #pragma unroll
      for(int i=0;i<4;++i){const int row=i*8+(lane>>3),ch=lane&7; const u32x4 v=*(const u32x4*)(stg+row*64+ch*8); ATTN_STORE16(Ow+(long)row*DM+hf*64+ch*8,v);}
      asm volatile("s_waitcnt lgkmcnt(0)":::"memory"); } }
  asm volatile("s_waitcnt lgkmcnt(0)\n\ts_barrier":::"memory");
  #undef DMA_K
  #undef DMA_V
  #undef CMASK
  #undef START
  #undef RESC
  #undef ROT
}
constexpr int ATTN_LDS_BYTES=LDS_BYTES;
#undef SBAR
#undef WAIT_BAR
}
constexpr int NWAVES = 8;
constexpr size_t MiB = 1u << 20;
constexpr size_t WS_CTL = 0, CTL_ZERO_BYTES = 64 * 1024;
constexpr size_t WS_SSQA = 1 * MiB, WS_SSQB = 2 * MiB;
constexpr size_t WS_SSQV = 3 * MiB;
constexpr size_t WS_SSQC = 4 * MiB + 512 * 1024;
constexpr size_t WS_ROPE = 5 * MiB;
constexpr size_t WS_WMIX = 9 * MiB, WS_W1 = 27 * MiB, WS_W2 = 35 * MiB;
constexpr size_t WS_XB = 43 * MiB;
constexpr size_t WS_ACT = 75 * MiB, WS_END = 267 * MiB;
constexpr int CW_BAR = 4096;
constexpr int RING_OFF = 0, RING_BYTES = 131072;
constexpr int LDSCTL_OFF = RING_BYTES, MISC_OFF = LDSCTL_OFF + 320;
constexpr int LDS_BYTES = 147456;
#define GAS __attribute__((address_space(1)))
#define LAS __attribute__((address_space(3)))
typedef unsigned short bf16;
typedef unsigned v4u __attribute__((ext_vector_type(4)));
typedef float f32x4 __attribute__((ext_vector_type(4)));
typedef short bf16x8 __attribute__((ext_vector_type(8)));
typedef GAS unsigned gu32;
typedef GAS unsigned long long gu64;
#define RLX_AGENT __ATOMIC_RELAXED, __HIP_MEMORY_SCOPE_AGENT
#define LDS_WAIT() asm volatile("s_waitcnt lgkmcnt(0)" ::: "memory")
#define VM_WAIT() asm volatile("s_waitcnt vmcnt(0)" ::: "memory")
__device__ __forceinline__ unsigned long long rt() { return __builtin_amdgcn_s_memrealtime(); }
__device__ __forceinline__ unsigned f2bf(float f) { unsigned u = __builtin_bit_cast(unsigned, f); return (u + 0x7fffu + ((u >> 16) & 1u)) >> 16; }
__device__ __forceinline__ unsigned pk2(float lo, float hi) { return f2bf(lo) | (f2bf(hi) << 16); }

#define XB_TMO      128
#define XB_XCNT(j)  (256  + 64 * (j))
#define XB_XSUB(j)  (1280 + 64 * (j))
#define XB_XGEN(j)  (2304 + 64 * (j))
#define XB_TOP      3328
#define XB_TOPGEN   3392
#define XCD_BAR_WORDS 3456
#define XB_SPIN_CAP (1u << 18)

__device__ __forceinline__ unsigned xb_ld(unsigned* p)              { return __hip_atomic_load(p, __ATOMIC_RELAXED, __HIP_MEMORY_SCOPE_AGENT); }
__device__ __forceinline__ unsigned xb_add(unsigned* p, unsigned v) { return __hip_atomic_fetch_add(p, v, __ATOMIC_RELAXED, __HIP_MEMORY_SCOPE_AGENT); }
__device__ __forceinline__ unsigned xb_xcc_id() { return (unsigned)__builtin_amdgcn_s_getreg((3 << 11) | 20) & 0xFu; }
#define XB_SPIN(cond, bar) do { unsigned _sp = 0; while (cond) { __builtin_amdgcn_s_sleep(1); \
    if ((++_sp & 255u) == 0u) { if (xb_ld(&(bar)[XB_TMO])) break; if (_sp > XB_SPIN_CAP) { atomicAdd(&(bar)[XB_TMO], 1u); break; } } } } while (0)

struct XcdBarrier {
    unsigned* bar; unsigned x;
    volatile LAS unsigned* st;
};

__device__ __forceinline__ XcdBarrier xcd_barrier_post(unsigned* bar, volatile LAS unsigned* st) {
    XcdBarrier b; b.bar = bar; b.x = xb_xcc_id(); b.st = st;
    if (threadIdx.x == 0) (void)xb_add(&bar[XB_XCNT(b.x)], 1u);
    return b;
}
__device__ __forceinline__ void xcd_barrier_complete(unsigned* bar, unsigned x, unsigned& nloc, unsigned& nx) {
    const unsigned G = gridDim.x * gridDim.y * gridDim.z;
    unsigned sum, cnt, mine, sp = 0u;
    for (;;) {
        sum = 0u; cnt = 0u; mine = 0u;
#pragma unroll
        for (unsigned j = 0; j < 16; ++j) { const unsigned c = xb_ld(&bar[XB_XCNT(j)]); sum += c; cnt += (c > 0u) ? 1u : 0u; mine = (j == x) ? c : mine; }
        if (sum == G) break;
        __builtin_amdgcn_s_sleep(1);
        if ((++sp & 255u) == 0u) { if (xb_ld(&bar[XB_TMO])) break; if (sp > XB_SPIN_CAP) { atomicAdd(&bar[XB_TMO], 1u); break; } }
    }
    nloc = mine > 0u ? mine : 1u; nx = cnt > 0u ? cnt : 1u;
}

__device__ __forceinline__ void xcd_barrier(const XcdBarrier& b) {
    asm volatile("s_waitcnt vmcnt(0)" ::: "memory");
    __syncthreads();
    if (threadIdx.x == 0) {
        unsigned* bar = b.bar;
        __builtin_amdgcn_s_waitcnt(0);
        unsigned nloc = b.st[0], nx = b.st[1];
        if (nloc == 0u) { xcd_barrier_complete(bar, b.x, nloc, nx); b.st[0] = nloc; b.st[1] = nx; }
        const unsigned old = xb_add(&bar[XB_XSUB(b.x)], 1u);
        const unsigned gen = old / nloc;
        if (old + 1u == (gen + 1u) * nloc) {
            __builtin_amdgcn_fence(__ATOMIC_RELEASE, "agent");
            asm volatile("s_waitcnt vmcnt(0)" ::: "memory");
            const unsigned og = xb_add(&bar[XB_TOP], 1u);
            const unsigned tg = og / nx;
            if (og + 1u == (tg + 1u) * nx) xb_add(&bar[XB_TOPGEN], 1u);
            else XB_SPIN(xb_ld(&bar[XB_TOPGEN]) == tg, bar);
            __builtin_amdgcn_fence(__ATOMIC_ACQUIRE, "agent");
            xb_add(&bar[XB_XGEN(b.x)], 1u);
            asm volatile("s_waitcnt vmcnt(0)" ::: "memory");
        } else {
            XB_SPIN(xb_ld(&bar[XB_XGEN(b.x)]) == gen, bar);
            __builtin_amdgcn_fence(__ATOMIC_ACQUIRE, "agent");
            asm volatile("s_waitcnt vmcnt(0)" ::: "memory");
        }
    }
    __syncthreads();
}
struct Args { const void* in[29]; float* out; unsigned char* ws; int ph_lo, ph_hi; };
struct Frame {
    LAS unsigned char* lds;
    volatile LAS unsigned* MISC;
    int tid, lane, wave, vcu, G;
};
typedef float f32x2v __attribute__((ext_vector_type(2)));
__device__ __forceinline__ float wave_sum(float v) {
#pragma unroll
    for (int o = 1; o < 64; o <<= 1) v += __shfl_xor(v, o);
    return v;
}
__device__ __forceinline__ void sincos_rev(double t, float& s, float& c) {
    t -= rint(t);
    const double k = rint(t * 4.0); const float f = (float)(t - k * 0.25), p = f * 6.2831853071795865f, p2 = p * p;
    const float sp = p * (1.0f + p2 * (-1.6666667163e-1f + p2 * (8.3333337680e-3f + p2 * (-1.9841270114e-4f + p2 * 2.7557314297e-6f))));
    const float cp = 1.0f + p2 * (-0.5f + p2 * (4.1666667908e-2f + p2 * (-1.3888889225e-3f + p2 * (2.4801587642e-5f + p2 * -2.7557314297e-7f))));
    const int q = ((int)k) & 3;
    s = (q == 0) ? sp : (q == 1) ? cp : (q == 2) ? -sp : -cp;
    c = (q == 0) ? cp : (q == 1) ? -sp : (q == 2) ? -cp : sp;
}
struct ConvJob { const float* W; int K, N; bf16* WT; const float* sv; int smask; float mul; int perm; };
__device__ __forceinline__ void transpose_item(const ConvJob& J, LAS float* scr, int item, int lane) {
    const int nblk = J.N / 32, kb = item / nblk, nb = item % nblk, k0 = 64 * kb, n0 = 32 * nb;
    f32x4 v[8];
    const float* src = J.W + (size_t)(k0 + (lane >> 3)) * J.N + n0 + 4 * (lane & 7);
#pragma unroll
    for (int i = 0; i < 8; ++i) v[i] = *(const f32x4*)(src + (size_t)(8 * i) * J.N);
    float sc[8];
#pragma unroll
    for (int i = 0; i < 8; ++i) { sc[i] = J.mul; if (J.sv) sc[i] *= J.sv[(k0 + 8 * i + (lane >> 3)) & J.smask]; }
#pragma unroll
    for (int i = 0; i < 8; ++i) { LAS float* d = scr + (8 * i + (lane >> 3)) * 33 + 4 * (lane & 7);
        d[0] = v[i][0] * sc[i]; d[1] = v[i][1] * sc[i]; d[2] = v[i][2] * sc[i]; d[3] = v[i][3] * sc[i]; }
    LDS_WAIT(); asm volatile("" ::: "memory");
    const int c = lane & 7;
#pragma unroll
    for (int j = 0; j < 4; ++j) { const int n = (lane >> 3) + 8 * j; const LAS float* s = scr + (8 * c) * 33 + n;
        v4u o; o.x = pk2(s[0 * 33], s[1 * 33]); o.y = pk2(s[2 * 33], s[3 * 33]); o.z = pk2(s[4 * 33], s[5 * 33]); o.w = pk2(s[6 * 33], s[7 * 33]);
        int nn = n0 + n; if (J.perm) { const int r = nn & 255; nn = (nn & ~255) + ((r >> 5) & 1) * 128 + (r >> 6) * 32 + (r & 31); }
        *(GAS v4u*)(J.WT + (size_t)nn * J.K + k0 + 8 * c) = o; }
    LDS_WAIT(); asm volatile("" ::: "memory");
}
__device__ __forceinline__ int conv_items(const ConvJob& J) { return (J.K / 64) * (J.N / 32); }
__device__ __forceinline__ void conv_run(Frame& F, const ConvJob& J0, const ConvJob& J1, const ConvJob& J2, const ConvJob& J3, const ConvJob& J4, int njobs) {
    LAS float* scr = (LAS float*)(F.lds + RING_OFF + F.wave * 16384);
    const int gw = F.vcu * NWAVES + F.wave, NGW = F.G * NWAVES;
    const int c0 = conv_items(J0), c1 = conv_items(J1), c2 = conv_items(J2), c3 = conv_items(J3), c4 = njobs > 4 ? conv_items(J4) : 0;
    const int total = c0 + c1 + c2 + c3 + c4;
    for (int it = gw; it < total; it += NGW) {
        int r = it;
        if (r < c0) { transpose_item(J0, scr, r, F.lane); continue; } r -= c0;
        if (r < c1) { transpose_item(J1, scr, r, F.lane); continue; } r -= c1;
        if (r < c2) { transpose_item(J2, scr, r, F.lane); continue; } r -= c2;
        if (r < c3) { transpose_item(J3, scr, r, F.lane); continue; } r -= c3;
        transpose_item(J4, scr, r, F.lane);
    }
}
[[maybe_unused]] __constant__ float INVF_TAB[32] = {1.000000000e+00f, 7.498942093e-01f, 5.623413252e-01f, 4.216965034e-01f, 3.162277660e-01f, 2.371373706e-01f, 1.778279410e-01f, 1.333521432e-01f, 1.000000000e-01f, 7.498942093e-02f, 5.623413252e-02f, 4.216965034e-02f, 3.162277660e-02f, 2.371373706e-02f, 1.778279410e-02f, 1.333521432e-02f, 1.000000000e-02f, 7.498942093e-03f, 5.623413252e-03f, 4.216965034e-03f, 3.162277660e-03f, 2.371373706e-03f, 1.778279410e-03f, 1.333521432e-03f, 1.000000000e-03f, 7.498942093e-04f, 5.623413252e-04f, 4.216965034e-04f, 3.162277660e-04f, 2.371373706e-04f, 1.778279410e-04f, 1.333521432e-04f};
__device__ __forceinline__ void init_phase(Frame& F, const float* x, bf16* XB, float* ssq0) {
    const int gw = F.vcu * NWAVES + F.wave, NGW = F.G * NWAVES;
    for (int m = gw; m < T_; m += NGW) {
        const GAS f32x4* xr = (const GAS f32x4*)(x + (size_t)m * 1024) + F.lane; GAS unsigned long long* o8 = (GAS unsigned long long*)(XB + (size_t)m * 1024) + F.lane;
        float s = 0.f;
#pragma unroll
        for (int j = 0; j < 4; ++j) { const f32x4 v = xr[64 * j]; s += (v.x * v.x + v.y * v.y) + (v.z * v.z + v.w * v.w);
            o8[64 * j] = (unsigned long long)pk2(v.x, v.y) | ((unsigned long long)pk2(v.z, v.w) << 32); }
        s = wave_sum(s); if (F.lane == 0) ssq0[m] = s;
    }
}
constexpr int ROWMETA_OFF = LDSCTL_OFF + 1024;
template <bool SLAB> __device__ __forceinline__ void stage_rowmeta(Frame& F, const float* ssq, const int* pos, int pm) {
    if (F.tid < 256) { const int row = pm * 256 + F.tid; LAS float* rsl = (LAS float*)(F.lds + ROWMETA_OFF);
        rsl[F.tid] = pg8::rs_of(SLAB ? pg8::slab16_sum(ssq, row) : ssq[row]);
        if (pos != nullptr) ((LAS int*)(F.lds + ROWMETA_OFF + 1024))[F.tid] = pos[row]; }
    __syncthreads();
}
__device__ __forceinline__ void warm_weights(Frame& F, const void* p, size_t bytes) {
    const size_t gt = ((size_t)(F.vcu * NWAVES + F.wave) * 64 + F.lane) * 16, step = (size_t)F.G * NWAVES * 64 * 16;
    v4u accv = (v4u){0u, 0u, 0u, 0u};
    for (size_t o = gt; o < bytes; o += step) { const v4u v = *(const v4u*)((const char*)p + o); accv.x ^= v.x; }
    asm volatile("" :: "v"(accv));
}
__device__ __forceinline__ void compact_phase(Frame& F, const float* slab, float* compact) {
    const int gt = (F.vcu * NWAVES + F.wave) * 64 + F.lane, NGT = F.G * NWAVES * 64;
    for (int r = gt; r < T_; r += NGT) compact[r] = pg8::slab16_sum(slab, r);
}
struct AttnU { int b, cq, cv, qb, o2; };
struct AttnOrder { int vcu, G;
    __device__ __forceinline__ bool next(int idx, AttnU& u) const { const int n = vcu + G * (idx >> 2); if (n >= 256) return false; const int i = idx & 3, h = (n >> 3) & 7, s = n & 7, c = i >> 1;
        u.b = n >> 6; u.cq = (2 * h + c) * 64; u.cv = h * 128; u.qb = (i & 1) ? 15 - s : s; u.o2 = c; return true; } };
__device__ __forceinline__ void attn_phase(Frame& F, unsigned char* ldsg, const bf16* Q, const bf16* K, const bf16* V, bf16* O1, bf16* O2, const float* lam4, int layer, const float* qg, const float* kg) {
    float sh; { float a = fabsf(qg[F.lane]), b2 = fabsf(kg[F.lane]);
#pragma unroll
      for (int o = 1; o < 64; o <<= 1) { a = fmaxf(a, __shfl_xor(a, o)); b2 = fmaxf(b2, __shfl_xor(b2, o)); }
      const float mb = 64.0f * a * b2 * (0.125f * 1.4426950408889634f);
      sh = __uint_as_float(__builtin_amdgcn_readfirstlane(__float_as_uint(fmaxf(mb - 60.0f, 0.f)))); }
    { AttnU u; AttnOrder S{F.vcu, F.G};
      for (int idx = 0; S.next(idx, u); ++idx) attn_body::attn_unit<8>(u.b, u.cq, u.cv, u.qb, (const attn_body::bf16*)Q, (const attn_body::bf16*)K, (const attn_body::bf16*)V, (attn_body::bf16*)(u.o2 ? O2 : O1), (char*)ldsg, sh); }
    VM_WAIT(); __syncthreads();
    const float la_ = wave_sum(lam4[F.lane] * lam4[64 + F.lane]), lb_ = wave_sum(lam4[128 + F.lane] * lam4[192 + F.lane]);
    const float lam = __expf(la_) - __expf(lb_) + ((layer == 0) ? 0.2f : 0.55605820415f);
    for (int n = F.vcu; n < 256; n += F.G) {
        const int b = n >> 6, h = (n >> 3) & 7, s = n & 7;
        for (int it = F.tid >> 4; it < 512; it += 32) { const int qb = (it >> 8) ? 15 - s : s; const size_t off = ((size_t)b * SEQ + qb * 256 + (it & 255)) * 1024 + h * 128 + 8 * (F.tid & 15);
            const v4u w1 = *(const v4u*)(O1 + off), w2 = *(const v4u*)(O2 + off); float d[8]; float ss = 0.f;
#pragma unroll
            for (int e = 0; e < 8; ++e) { const unsigned x1 = w1[e >> 1], x2 = w2[e >> 1];
                const float f1 = (e & 1) ? __uint_as_float(x1 & 0xffff0000u) : __uint_as_float(x1 << 16), f2 = (e & 1) ? __uint_as_float(x2 & 0xffff0000u) : __uint_as_float(x2 << 16);
                d[e] = f1 - lam * f2; ss += d[e] * d[e]; }
            ss += __shfl_xor(ss, 1); ss += __shfl_xor(ss, 2); ss += __shfl_xor(ss, 4); ss += __shfl_xor(ss, 8);
            const float r = __builtin_amdgcn_rsqf(ss * (1.0f / 128.0f) + 1e-6f);
            v4u o; o.x = pk2(d[0] * r, d[1] * r); o.y = pk2(d[2] * r, d[3] * r); o.z = pk2(d[4] * r, d[5] * r); o.w = pk2(d[6] * r, d[7] * r);
            *(v4u*)(O1 + off) = o; }
    }
}
constexpr int SSM_KT = 0, SSM_BS = 9216, SSM_CC = 9216 + 65536, SSM_L16 = 9216 + 131072, SSM_TSTRIDE = 9216 + 131072 + 512;
__device__ __forceinline__ void ssm_tables(Frame& F, unsigned char* tabs, const float* a_re, const float* a_im, const float* b_re, const float* b_im, const float* c_re, const float* c_im, const float* log_dt) {
    LAS f32x2v* pw = (LAS f32x2v*)F.lds;
    LAS f32x2v* zo = pw + 17 * 64;
    LAS f32x2v* Bb = zo + 64;
    LAS f32x2v* Cc = Bb + 1024;
    for (int n = F.vcu; n < 256; n += F.G) {
        const int g = n & 63, q = n >> 6;
        if (F.tid < 64) { const int p = F.tid;
            const float are = fminf(a_re[g * 64 + p], -1e-4f), aim = a_im[g * 64 + p];
            const float dt = __expf(log_dt[g]), er = __expf(are * dt); float sn, cs; sincos_rev((double)aim * (double)dt * 0.15915494309189533577, sn, cs);
            const float lbr = er * cs, lbi = er * sn;
            const float nr = lbr - 1.0f, ni = lbi, den = are * are + aim * aim;
            zo[p] = (f32x2v){(nr * are + ni * aim) / den, (ni * are - nr * aim) / den};
            float pr = 1.f, pi = 0.f;
            for (int t = 0; t <= 16; ++t) { pw[t * 64 + p] = (f32x2v){pr, pi}; const float a = pr * lbr - pi * lbi, b2 = pr * lbi + pi * lbr; pr = a; pi = b2; } }
        __syncthreads();
        for (int e = F.tid; e < 1024; e += 512) { const f32x2v z = zo[e >> 4]; const float br = b_re[g * 1024 + e], bi = b_im[g * 1024 + e];
            Bb[e] = (f32x2v){z.x * br - z.y * bi, z.x * bi + z.y * br}; Cc[e] = (f32x2v){c_re[g * 1024 + e], c_im[g * 1024 + e]}; }
        __syncthreads();
        unsigned char* tg = tabs + (size_t)g * SSM_TSTRIDE;
        { bf16* kt = (bf16*)(tg + SSM_KT);
          for (int e = q * 1088 + F.tid; e < (q + 1) * 1088; e += 512) { const int lp1 = e >> 8, ho = (e >> 4) & 15, hi = e & 15; float acc = 0.f;
              if (lp1 > 0) for (int p = 0; p < 64; ++p) { const f32x2v c = Cc[ho * 64 + p], l = pw[(lp1 - 1) * 64 + p], b = Bb[p * 16 + hi];
                  const float tr = c.x * l.x - c.y * l.y, ti = c.x * l.y + c.y * l.x; acc += tr * b.x - ti * b.y; }
              kt[e] = (bf16)f2bf(acc); }
          if (q == 0 && F.tid < 64) ((f32x2v*)(tg + SSM_L16))[F.tid] = pw[16 * 64 + F.tid]; }
        { bf16* bs = (bf16*)(tg + SSM_BS);
          for (int e = q * 8192 + F.tid; e < (q + 1) * 8192; e += 512) { const int r = e >> 8, k = e & 255, i = k >> 4, hi = k & 15, p = r & 63;
              const f32x2v l = pw[(15 - i) * 64 + p], b = Bb[p * 16 + hi]; const float mr = l.x * b.x - l.y * b.y, mi = l.x * b.y + l.y * b.x;
              bs[e] = (bf16)f2bf((r >> 6) ? mi : mr); } }
        { bf16* cc = (bf16*)(tg + SSM_CC);
          for (int e = q * 8192 + F.tid; e < (q + 1) * 8192; e += 512) { const int row = e >> 7, k = e & 127, jj = row >> 4, ho = row & 15, p = k >> 1;
              const f32x2v c = Cc[ho * 64 + p], l = pw[(jj + 1) * 64 + p]; const float mr = c.x * l.x - c.y * l.y, mi = c.x * l.y + c.y * l.x;
              cc[e] = (bf16)f2bf((k & 1) ? -mi : mr); } }
        __syncthreads();
    }
}
#ifndef DBG_SSM_SKIP
#define DBG_SSM_SKIP 0
#endif
#define SSM_DBG(bit) (dbg && ((DBG_SSM_SKIP >> (bit)) & 1))
__device__ __forceinline__ void ssm_phase(Frame& F, const bf16* U, bf16* GA, const unsigned char* tabs, const float* dsk, const int dbg) {
    const int lane = F.lane, w = F.wave, lr = lane & 15, kq = lane >> 4;
    LAS unsigned short* Ul = (LAS unsigned short*)F.lds;
    LAS float* El = (LAS float*)(F.lds + 33792);
    LAS unsigned short* Sb = (LAS unsigned short*)(F.lds + 33792 + 33280);
    LAS unsigned short* Kt = (LAS unsigned short*)(F.lds + 33792 + 33280 + 17408);
    for (int item = F.vcu; item < (SSM_DBG(4) ? 0 : 256); item += F.G) {
        const int b = item >> 6, g = item & 63;
        const unsigned char* tg = tabs + (size_t)g * SSM_TSTRIDE;
        for (int q = F.tid; q < 544; q += 512) *(LAS v4u*)(Kt + q * 8) = *(const v4u*)(tg + SSM_KT + q * 16);
        bf16x8 Abs[8], Acc[2][4];
#pragma unroll
        for (int ks = 0; ks < 8; ++ks) Abs[ks] = *(const bf16x8*)(tg + SSM_BS + ((16 * w + lr) * 256 + 32 * ks + 8 * kq) * 2);
#pragma unroll
        for (int jj = 0; jj < 2; ++jj) { const int j = jj ? 15 - w : w;
#pragma unroll
            for (int ks = 0; ks < 4; ++ks) Acc[jj][ks] = *(const bf16x8*)(tg + SSM_CC + ((j * 16 + lr) * 128 + 32 * ks + 8 * kq) * 2); }
        const f32x2v l16 = ((const f32x2v*)(tg + SSM_L16))[lane];
        const f32x4 dskv = *(const f32x4*)(dsk + g * 16 + 4 * kq);
        float sre = 0.f, sim = 0.f;
        const size_t rowbase = (size_t)b * SEQ;
        v4u upre[4];
#pragma unroll
        for (int i = 0; i < 4; ++i) { const int q = F.tid + 512 * i; upre[i] = *(const v4u*)(U + (rowbase + (q >> 1)) * 1024 + g * 16 + (q & 1) * 8); }
        for (int seg = 0; seg < 4; ++seg) {
#pragma unroll
            for (int i = 0; i < 4; ++i) { const int q = F.tid + 512 * i, t = q >> 1, hf = q & 1; *(LAS v4u*)(Ul + (t >> 4) * 264 + (t & 15) * 16 + hf * 8) = upre[i]; }
            if (seg < 3) {
#pragma unroll
                for (int i = 0; i < 4; ++i) { const int q = F.tid + 512 * i; upre[i] = *(const v4u*)(U + (rowbase + (seg + 1) * 1024 + (q >> 1)) * 1024 + g * 16 + (q & 1) * 8); } }
            __syncthreads();
            if (!SSM_DBG(3)) { f32x4 acc[4];
#pragma unroll
              for (int nb = 0; nb < 4; ++nb) acc[nb] = (f32x4){0.f, 0.f, 0.f, 0.f};
#pragma unroll
              for (int ks = 0; ks < 8; ++ks)
#pragma unroll
                  for (int nb = 0; nb < 4; ++nb) { const bf16x8 Bf = *(const LAS bf16x8*)(Ul + (16 * nb + lr) * 264 + (2 * ks + (kq >> 1)) * 16 + (kq & 1) * 8);
                      acc[nb] = __builtin_amdgcn_mfma_f32_16x16x32_bf16(Abs[ks], Bf, acc[nb], 0, 0, 0); }
#pragma unroll
              for (int nb = 0; nb < 4; ++nb)
#pragma unroll
                  for (int r = 0; r < 4; ++r) El[(16 * w + 4 * kq + r) * 65 + 16 * nb + lr] = acc[nb][r]; }
            __syncthreads();
            if (w == 0 && !SSM_DBG(0)) {
                for (int k0 = 0; k0 < 64; k0 += 16) { float er[16], ei[16];
#pragma unroll
                    for (int kk = 0; kk < 16; ++kk) { er[kk] = El[lane * 65 + k0 + kk]; ei[kk] = El[(64 + lane) * 65 + k0 + kk]; }
#pragma unroll
                    for (int kk = 0; kk < 16; ++kk) { *(LAS unsigned*)(Sb + (k0 + kk) * 136 + 2 * lane) = pg8::cvt_pk_bf16(sre, sim);
                        const float a = l16.x * sre - l16.y * sim + er[kk], b2 = l16.x * sim + l16.y * sre + ei[kk]; sre = a; sim = b2; } } }
            __syncthreads();
#pragma unroll
            for (int jj = 0; jj < 2; ++jj) { const int j = jj ? 15 - w : w;
                f32x4 acc[4];
#pragma unroll
                for (int nb = 0; nb < 4; ++nb) acc[nb] = (f32x4){0.f, 0.f, 0.f, 0.f};
                if (!SSM_DBG(1)) { bf16x8 Af[8];
#pragma unroll
                for (int ks = 0; ks < 8; ++ks) { int lp1 = j - 2 * ks - (kq >> 1) + 1; lp1 = lp1 < 0 ? 0 : lp1; Af[ks] = *(const LAS bf16x8*)(Kt + lp1 * 256 + lr * 16 + (kq & 1) * 8); }
#pragma unroll
                for (int nb = 0; nb < 4; ++nb) { bf16x8 Bf[8];
#pragma unroll
                    for (int ks = 0; ks < 8; ++ks) Bf[ks] = *(const LAS bf16x8*)(Ul + (16 * nb + lr) * 264 + (2 * ks + (kq >> 1)) * 16 + (kq & 1) * 8);
#pragma unroll
                    for (int ks = 0; ks < 8; ++ks) acc[nb] = __builtin_amdgcn_mfma_f32_16x16x32_bf16(Af[ks], Bf[ks], acc[nb], 0, 0, 0);
                    asm volatile("" ::: "memory"); } }
#pragma unroll
                for (int ks = 0; ks < 4; ++ks)
#pragma unroll
                    for (int nb = 0; nb < 4; ++nb) { const bf16x8 Bf = *(const LAS bf16x8*)(Sb + (16 * nb + lr) * 136 + 32 * ks + 8 * kq);
                        acc[nb] = __builtin_amdgcn_mfma_f32_16x16x32_bf16(Acc[jj][ks], Bf, acc[nb], 0, 0, 0); }
#pragma unroll
                for (int nb = 0; nb < 4; ++nb) { const int n = 16 * nb + lr; const int ts = 16 * n + j;
                    const unsigned long long uu = *(const LAS unsigned long long*)(Ul + n * 264 + j * 16 + 4 * kq);
                    const float u0 = __uint_as_float((unsigned)uu << 16), u1 = __uint_as_float((unsigned)uu & 0xffff0000u), u2 = __uint_as_float((unsigned)(uu >> 32) << 16), u3 = __uint_as_float((unsigned)(uu >> 32) & 0xffff0000u);
                    const float y0 = pg8::gelu_tanh(acc[nb][0] + dskv[0] * u0), y1 = pg8::gelu_tanh(acc[nb][1] + dskv[1] * u1), y2 = pg8::gelu_tanh(acc[nb][2] + dskv[2] * u2), y3 = pg8::gelu_tanh(acc[nb][3] + dskv[3] * u3);
                    if (!SSM_DBG(2)) *(unsigned long long*)(GA + (rowbase + seg * 1024 + ts) * 1024 + g * 16 + 4 * kq) = (unsigned long long)pk2(y0, y1) | ((unsigned long long)pk2(y2, y3) << 32); } }
            __syncthreads();
        }
    }
}
__device__ __forceinline__ void gate_phase(Frame& F, bf16* ZU, const bf16* ZVT, const float* ssqv, const float* Ws, const float* bs, const float* vg) {
    LAS unsigned short* Al = (LAS unsigned short*)F.lds;
    const int lane = F.lane, lr = lane & 15, kq = lane >> 4, s = F.tid & 127, t0 = F.tid >> 7;
    bf16x8 Bf[3][4]; float wv[32];
#define GATE_PREFETCH(nn) do { const int h_ = (nn) & 7, tok_ = ((nn) >> 8) * SEQ + (((nn) >> 3) & 31) * 128, dw_ = h_ * 384 + 48 * F.wave; \
        _Pragma("unroll") for (int db = 0; db < 3; ++db) _Pragma("unroll") for (int ks = 0; ks < 4; ++ks) Bf[db][ks] = *(const bf16x8*)(ZVT + (size_t)(dw_ + 16 * db + lr) * T_ + tok_ + 32 * ks + 8 * kq); \
        _Pragma("unroll") for (int k = 0; k < 32; ++k) wv[k] = Ws[(size_t)(h_ * 128 + t0 + 4 * k) * 128 + s]; } while (0)
    int n = F.vcu;
    if (n < 1024) GATE_PREFETCH(n);
    for (; n < 1024; n += F.G) {
        const int b = n >> 8, ch = (n >> 3) & 31, h = n & 7; const int tok0 = b * SEQ + ch * 128;
        const int dw = h * 384 + 48 * F.wave;
        unsigned long long uu[8][3];
#pragma unroll
        for (int tb = 0; tb < 8; ++tb)
#pragma unroll
            for (int db = 0; db < 3; ++db) uu[tb][db] = *(const unsigned long long*)(ZU + (size_t)(tok0 + 16 * tb + lr) * GH + dw + 16 * db + 4 * kq);
        { const f32x4* sp = (const f32x4*)(ssqv + (size_t)(tok0 + s) * 24); float sv = 0.f;
#pragma unroll
          for (int q = 0; q < 6; ++q) { const f32x4 a = sp[q]; sv += (a[0] + a[1]) + (a[2] + a[3]); }
          const float rv = __builtin_amdgcn_rsqf(sv * (1.0f / 3072.0f) + 1e-6f);
#pragma unroll
          for (int k = 0; k < 32; ++k) { const int t = t0 + 4 * k; Al[t * 136 + s] = (unsigned short)f2bf((s <= t) ? wv[k] * rv : 0.f); } }
        __syncthreads();
        bf16x8 Bc[3][4];
#pragma unroll
        for (int db = 0; db < 3; ++db)
#pragma unroll
            for (int ks = 0; ks < 4; ++ks) Bc[db][ks] = Bf[db][ks];
        if (n + F.G < 1024) GATE_PREFETCH(n + F.G);
#pragma unroll
        for (int tb = 0; tb < 8; ++tb) {
            f32x4 acc[3];
#pragma unroll
            for (int db = 0; db < 3; ++db) acc[db] = (f32x4){0.f, 0.f, 0.f, 0.f};
#pragma unroll
            for (int ks = 0; ks < 4; ++ks) if (ks <= tb / 2) {
                const bf16x8 Af = *(const LAS bf16x8*)(Al + (16 * tb + lr) * 136 + 32 * ks + 8 * kq);
#pragma unroll
                for (int db = 0; db < 3; ++db) acc[db] = __builtin_amdgcn_mfma_f32_16x16x32_bf16(Bc[db][ks], Af, acc[db], 0, 0, 0); }
            const int t = 16 * tb + lr; const float bsv = bs[h * 128 + t];
#pragma unroll
            for (int db = 0; db < 3; ++db) { const int dcol = dw + 16 * db + 4 * kq; const f32x4 gv = *(const f32x4*)(vg + dcol); const unsigned long long u8 = uu[tb][db];
                const float u0 = __uint_as_float((unsigned)u8 << 16), u1 = __uint_as_float((unsigned)u8 & 0xffff0000u), u2 = __uint_as_float((unsigned)(u8 >> 32) << 16), u3 = __uint_as_float((unsigned)(u8 >> 32) & 0xffff0000u);
                const float o0 = u0 * (acc[db][0] * gv[0] + bsv), o1 = u1 * (acc[db][1] * gv[1] + bsv), o2 = u2 * (acc[db][2] * gv[2] + bsv), o3 = u3 * (acc[db][3] * gv[3] + bsv);
                *(unsigned long long*)(ZU + (size_t)(tok0 + t) * GH + dcol) = (unsigned long long)pk2(o0, o1) | ((unsigned long long)pk2(o2, o3) << 32); }
        }
        __syncthreads();
    }
#undef GATE_PREFETCH
}
__device__ __forceinline__ bool step_exists(int st) { return !((st % 7) == 3 && ((st / 7) % 3) != 1); }
typedef const __attribute__((address_space(4))) char* kargp_t;
__device__ __forceinline__ kargp_t kargs() { kargp_t kp = (kargp_t)__builtin_amdgcn_kernarg_segment_ptr(); asm volatile("" : "+s"(kp)); return kp; }
#define ARGP(i) (*(const void* const __attribute__((address_space(4)))*)(kp + 8 * (i)))
#define ARGI(off) (*(const int __attribute__((address_space(4)))*)(kp + (off)))
__device__ __forceinline__ void run_step(const int st, unsigned char* lds, const int rep) {
    kargp_t kp = kargs();
    Frame F;
    F.lds = (LAS unsigned char*)lds; asm volatile("" : "+s"(F.lds));
    F.MISC = (volatile LAS unsigned*)(F.lds + MISC_OFF);
    F.tid = tid_fresh(); F.G = gridDim.x; int bx = blockIdx.x;
    asm volatile("" : "+s"(F.G), "+s"(bx));
    F.lane = F.tid & 63; F.wave = __builtin_amdgcn_readfirstlane(F.tid >> 6);
    F.vcu = (F.G % 8 == 0) ? (bx % 8) * (F.G / 8) + bx / 8 : bx;
    unsigned char* ws = (unsigned char*)ARGP(30);
    bf16* WMIX = (bf16*)(ws + WS_WMIX); bf16* XB = (bf16*)(ws + WS_XB);
    unsigned char* act = ws + WS_ACT;
    const int layer = st / 7, slot = st % 7, kind = layer % 3, j = layer / 3;
    float* ssq_in = (float*)(ws + WS_SSQC);
    float* ssq_mid = (float*)(ws + WS_SSQB);
    float* ssq_out = (float*)(ws + WS_SSQA);
    float* ssqv = (float*)(ws + WS_SSQV);
    if (slot == 0) {
        const float* norm_mix = (const float*)ARGP(2); const float* norm_mlp = (const float*)ARGP(3);
        ConvJob J0{}, J1{}, J2{}, J3{}, J4{}; int nj = 4;
        if (kind == 0) {
            J0 = ConvJob{(const float*)ARGP(6) + (size_t)j * 1024 * 3072, 1024, 3072, WMIX, norm_mix + layer * 1024, 1023, 1.f, 1};
            J1 = ConvJob{(const float*)ARGP(11) + (size_t)j * 1024 * 1024, 1024, 1024, WMIX + 3 * MiB, (const float*)ARGP(10) + j * 128, 127, (layer == 0) ? 0.8f : 0.44394179585f, 0};
        } else if (kind == 1) {
            J0 = ConvJob{(const float*)ARGP(12) + (size_t)j * 1024 * 1024, 1024, 1024, WMIX, norm_mix + layer * 1024, 1023, 1.f, 0};
            J1 = ConvJob{(const float*)ARGP(21) + (size_t)j * 1024 * 1024, 1024, 1024, WMIX + 1 * MiB, nullptr, 0, 1.f, 0};
            J4 = ConvJob{(const float*)ARGP(23) + (size_t)j * 1024 * 1024, 1024, 1024, WMIX + 2 * MiB, nullptr, 0, 1.f, 0}; nj = 5;
        } else {
            J0 = ConvJob{(const float*)ARGP(24) + (size_t)j * 1024 * 6144, 1024, 6144, WMIX, norm_mix + layer * 1024, 1023, 1.f, 0};
            J1 = ConvJob{(const float*)ARGP(28) + (size_t)j * 3072 * 1024, 3072, 1024, WMIX + 6 * MiB, nullptr, 0, 1.f, 0};
        }
        J2 = ConvJob{(const float*)ARGP(4) + (size_t)layer * 1024 * 4096, 1024, 4096, (bf16*)(ws + WS_W1), norm_mlp + layer * 1024, 1023, 1.f, 0};
        J3 = ConvJob{(const float*)ARGP(5) + (size_t)layer * 4096 * 1024, 4096, 1024, (bf16*)(ws + WS_W2), nullptr, 0, 1.f, 0};
        conv_run(F, J0, J1, J2, J3, J4, nj);
        if (layer == 0) init_phase(F, (const float*)ARGP(0), XB, ssq_in);
        else compact_phase(F, ssq_out, ssq_in);
        if (kind == 1) ssm_tables(F, act + 96 * MiB, (const float*)ARGP(13) + j * 4096, (const float*)ARGP(14) + j * 4096, (const float*)ARGP(15) + (size_t)j * 65536, (const float*)ARGP(16) + (size_t)j * 65536,
                                  (const float*)ARGP(17) + (size_t)j * 65536, (const float*)ARGP(18) + (size_t)j * 65536, (const float*)ARGP(20) + j * 64);
    } else if (slot == 1) {
        const LAS float* rsl = (const LAS float*)(F.lds + ROWMETA_OFF); const LAS int* posl = (const LAS int*)(F.lds + ROWMETA_OFF + 1024);
        if (kind == 0) {
            pg8::Gemm g{XB, WMIX, T_, 3072, 1024}; pg8::StaticOrder S; S.init(T_, 3072, F.G, bx);
            { pg8::Unit u0; S.next(0, u0); stage_rowmeta<false>(F, ssq_in, (const int*)ARGP(1), u0.pm); }
            pg8::EpiQKV E{(bf16*)act, (bf16*)(act + 32 * MiB), (bf16*)(act + 64 * MiB), rsl, posl, (const float*)ARGP(7) + j * 64, (const float*)ARGP(8) + j * 64};
            pg8::gemm_phase<pg8::EpiQKV, pg8::StaticOrder, true, true>(F.lds + RING_OFF, g, S, E);
        } else if (kind == 1) {
            pg8::Gemm g{XB, WMIX, T_, 1024, 1024}; pg8::StaticOrder S; S.init(T_, 1024, F.G, bx);
            { pg8::Unit u0; S.next(0, u0); stage_rowmeta<false>(F, ssq_in, nullptr, u0.pm); }
            pg8::EpiRowScale<0> E{(bf16*)act, 1024, rsl, 0};
            pg8::gemm_phase<pg8::EpiRowScale<0>, pg8::StaticOrder, true, true>(F.lds + RING_OFF, g, S, E);
        } else {
            { pg8::Gemm g{XB, WMIX, T_, GH, 1024}; pg8::StaticOrder S; S.init(T_, GH, F.G, bx);
              { pg8::Unit u0; S.next(0, u0); stage_rowmeta<false>(F, ssq_in, nullptr, u0.pm); }
              pg8::EpiRowScale<2> E{(bf16*)act, GH, rsl, 0};
              pg8::gemm_phase<pg8::EpiRowScale<2>, pg8::StaticOrder, true, true>(F.lds + RING_OFF, g, S, E); }
            { pg8::Gemm g{WMIX + (size_t)GH * 1024, XB, GH, T_, 1024}; pg8::StaticOrder S; S.init(GH, T_, F.G, bx);
              pg8::EpiGmV E{(bf16*)(act + 96 * MiB), T_, ssq_in, ssqv};
              pg8::gemm_phase<pg8::EpiGmV, pg8::StaticOrder, true, true>(F.lds + RING_OFF, g, S, E); }
        }
    } else if (slot == 2) {
        if (kind == 0) attn_phase(F, lds + RING_OFF, (const bf16*)act, (const bf16*)(act + 32 * MiB), (const bf16*)(act + 64 * MiB), (bf16*)(act + 96 * MiB), (bf16*)(act + 128 * MiB),
                                  (const float*)ARGP(9) + j * 256, layer, (const float*)ARGP(7) + j * 64, (const float*)ARGP(8) + j * 64);
        else if (kind == 1) ssm_phase(F, (const bf16*)act, (bf16*)(act + (rep ? 64 : 32) * MiB), act + 96 * MiB, (const float*)ARGP(19) + j * 1024, rep);
        else gate_phase(F, (bf16*)act, (const bf16*)(act + 96 * MiB), ssqv, (const float*)ARGP(26) + (size_t)j * 8 * 128 * 128, (const float*)ARGP(27) + j * 1024, (const float*)ARGP(25) + j * GH);
    } else if (slot == 3) {
        pg8::Gemm g{(const bf16*)(act + 32 * MiB), WMIX + 1 * MiB, T_, 1024, 1024}; pg8::StaticOrder S; S.init(T_, 1024, F.G, bx);
        pg8::EpiGlu E{(bf16*)(act + 64 * MiB), (const bf16*)(act + 32 * MiB), (const float*)ARGP(22) + j * 1024};
        pg8::gemm_phase<pg8::EpiGlu, pg8::StaticOrder, true, true>(F.lds + RING_OFF, g, S, E);
    } else if (slot == 4 || slot == 6) {
        float* out = (st == 27) ? (float*)ARGP(29) : nullptr;
        const bf16* A; const bf16* Bt; int K; float* sq;
        if (slot == 6) { A = (const bf16*)act; Bt = (const bf16*)(ws + WS_W2); K = 4096; sq = (layer < 3) ? ssq_out : nullptr; }
        else { sq = ssq_mid;
            if (kind == 0) { A = (const bf16*)(act + 96 * MiB); Bt = WMIX + 3 * MiB; K = 1024; }
            else if (kind == 1) { A = (const bf16*)(act + 64 * MiB); Bt = WMIX + 2 * MiB; K = 1024; }
            else { A = (const bf16*)act; Bt = WMIX + 6 * MiB; K = GH; } }
        pg8::Gemm g{A, Bt, T_, 1024, K}; pg8::StaticOrder S; S.init(T_, 1024, F.G, bx);
        pg8::EpiRes E{out, XB, sq};
        pg8::gemm_phase<pg8::EpiRes, pg8::StaticOrder, true, true>(F.lds + RING_OFF, g, S, E);
    } else {
        pg8::Gemm g{XB, (const bf16*)(ws + WS_W1), T_, FF, 1024}; pg8::StaticOrder S; S.init(T_, FF, F.G, bx);
#ifdef DBG_MLP1_UNITS
        if (rep) S.nwg = 256 * DBG_MLP1_UNITS;
#endif
        warm_weights(F, ws + WS_W1, (size_t)FF * 1024 * 2);
        { pg8::Unit u0; S.next(0, u0); stage_rowmeta<true>(F, ssq_mid, nullptr, u0.pm); }
#ifdef DBG_STAGGER
        { const unsigned long long t0_ = __builtin_amdgcn_s_memrealtime(); const unsigned long long dl_ = (unsigned long long)(F.vcu >> 5) * DBG_STAGGER; while (__builtin_amdgcn_s_memrealtime() - t0_ < dl_) __builtin_amdgcn_s_sleep(4); }
#endif
        pg8::EpiRowScale<1> E{(bf16*)act, FF, (const LAS float*)(F.lds + ROWMETA_OFF), rep};
        pg8::gemm_phase<pg8::EpiRowScale<1>, pg8::StaticOrder, true, true>(F.lds + RING_OFF, g, S, E);
    }
}
__global__ void __launch_bounds__(NWAVES * 64, 2) trunk_fwd(Args args) {
    extern __shared__ __attribute__((aligned(16))) unsigned char lds[];
    for (int u = threadIdx.x; u < (LDS_BYTES - LDSCTL_OFF) / 4; u += NWAVES * 64) ((LAS unsigned*)((LAS unsigned char*)lds + LDSCTL_OFF))[u] = 0u;
    __syncthreads();
    if (args.ph_hi - args.ph_lo > 1) (void)xcd_barrier_post((unsigned*)((gu32*)(args.ws + WS_CTL) + CW_BAR), (volatile LAS unsigned*)((LAS unsigned char*)lds + MISC_OFF) + 8);
    int st = args.ph_lo;
#ifndef DBG_REPEAT_MASK
#define DBG_REPEAT_MASK 0u
#endif
    int rep = 0;
    for (;;) {
        { kargp_t kp = kargs(); if (st >= ARGI(252)) break; }
        if (step_exists(st)) {
#ifdef DBG_TIME_STEP
#ifndef DBG_TIME_BLOCK
#define DBG_TIME_BLOCK 0
#endif
#ifndef DBG_TIME_REP
#define DBG_TIME_REP 0
#endif
            unsigned long long tc0_ = 0, tr0_ = 0; if (st == DBG_TIME_STEP && rep == DBG_TIME_REP) { tc0_ = __builtin_amdgcn_s_memtime(); tr0_ = __builtin_amdgcn_s_memrealtime(); }
#ifdef DBG_TIME_INCL_BAR
            if (st == DBG_TIME_STEP && blockIdx.x == DBG_TIME_BLOCK && threadIdx.x == 0) { volatile LAS unsigned* M_ = (volatile LAS unsigned*)((LAS unsigned char*)lds + MISC_OFF); M_[18] = (unsigned)tr0_; }
            if (st == DBG_TIME_STEP + DBG_TIME_INCL_BAR && blockIdx.x == DBG_TIME_BLOCK && threadIdx.x == 0) { volatile LAS unsigned* M_ = (volatile LAS unsigned*)((LAS unsigned char*)lds + MISC_OFF); M_[19] = (unsigned)__builtin_amdgcn_s_memrealtime() - M_[18]; }
#endif
#endif
            run_step(st, lds, rep);
#ifdef DBG_TIME_STEP
            if (st == DBG_TIME_STEP && rep == DBG_TIME_REP && blockIdx.x == DBG_TIME_BLOCK && threadIdx.x == 0) { const unsigned long long tc1_ = __builtin_amdgcn_s_memtime(), tr1_ = __builtin_amdgcn_s_memrealtime();
                volatile LAS unsigned* M_ = (volatile LAS unsigned*)((LAS unsigned char*)lds + MISC_OFF); M_[16] = (unsigned)(tc1_ - tc0_); M_[17] = (unsigned)(tr1_ - tr0_); }
#endif
            kargp_t kp = kargs();
            if (st + 1 < ARGI(252) || (DBG_REPEAT_MASK != 0u && ((DBG_REPEAT_MASK >> st) & 1u))) { XcdBarrier bar; bar.bar = (unsigned*)((gu32*)((unsigned char*)ARGP(30) + WS_CTL) + CW_BAR); bar.x = xb_xcc_id(); bar.st = (volatile LAS unsigned*)((LAS unsigned char*)lds + MISC_OFF) + 8;
                xcd_barrier(bar); }
        }
#ifndef DBG_REPEAT_N
#define DBG_REPEAT_N 1
#endif
        if (DBG_REPEAT_MASK != 0u && rep < DBG_REPEAT_N && ((DBG_REPEAT_MASK >> st) & 1u)) ++rep; else { rep = 0; ++st; }
    }
#ifdef DBG_TIME_STEP
    if (blockIdx.x == DBG_TIME_BLOCK && threadIdx.x == 0) { volatile LAS unsigned* M_ = (volatile LAS unsigned*)((LAS unsigned char*)lds + MISC_OFF); const unsigned cyc = M_[16];
#ifdef DBG_TIME_INCL_BAR
        const unsigned rt = M_[19];
#else
        const unsigned rt = M_[17];
#endif
        unsigned long long wait_ticks = (DBG_TIME_MODE == 0) ? (unsigned long long)rt * 10ull : (unsigned long long)(((double)cyc / (double)rt) * 10000.0);
        const unsigned long long t0 = __builtin_amdgcn_s_memrealtime(); while (__builtin_amdgcn_s_memrealtime() - t0 < wait_ticks) __builtin_amdgcn_s_sleep(16); }
#endif
}

#ifdef DBG_DUMP_OFF
__global__ void dbg_dump(const unsigned short* src, float* out, int n) { for (int i = blockIdx.x * blockDim.x + threadIdx.x; i < n; i += gridDim.x * blockDim.x) out[i] = __uint_as_float((unsigned)src[i] << 16); }
#endif
#ifndef MK_PER_PHASE
#define MK_PER_PHASE 0
#endif
extern "C" void kernel_launch(void* const* d_in, const int* in_sizes, int n_in, void* d_out, int out_size, void* d_ws, size_t ws_size, hipStream_t stream) {
    static int grid = 0;
    static_assert(sizeof(Args) == 256, "Args layout: in[29] at 0, out at 232, ws at 240, ph_lo 248, ph_hi 252");
    if (grid == 0) {
        if (n_in != 29 || in_sizes[0] != T_ * 1024 || out_size != T_ * 1024 || ws_size < WS_END) { fprintf(stderr, "kernel_launch: unexpected shapes / workspace (n_in %d, ws %zu); nothing launched\n", n_in, ws_size); grid = -1; return; }
        int dev = 0, cus = 0;
        if (hipGetDevice(&dev) != hipSuccess || hipDeviceGetAttribute(&cus, hipDeviceAttributeMultiprocessorCount, dev) != hipSuccess) { grid = -1; return; }
        if (hipFuncSetAttribute((const void*)trunk_fwd, hipFuncAttributeMaxDynamicSharedMemorySize, LDS_BYTES) != hipSuccess) { fprintf(stderr, "kernel_launch: hipFuncSetAttribute failed\n"); grid = -1; return; }
        int per_cu = 0; (void)hipOccupancyMaxActiveBlocksPerMultiprocessor(&per_cu, (const void*)trunk_fwd, NWAVES * 64, LDS_BYTES); (void)hipGetLastError();
        if (per_cu < 1) fprintf(stderr, "kernel_launch: occupancy query reports %d blocks per CU\n", per_cu);
        if (cus != 256) { fprintf(stderr, "kernel_launch: built for a 256-CU device (one 256-row panel per workgroup in the GEMM phases); this device reports %d CUs; nothing launched\n", cus); grid = -1; return; }
        grid = cus;
    }
    if (grid < 0) return;
    (void)hipMemsetAsync((char*)d_ws + WS_CTL, 0, CTL_ZERO_BYTES, stream);
    Args a{};
    for (int i = 0; i < 29; ++i) a.in[i] = d_in[i];
    a.out = (float*)d_out; a.ws = (unsigned char*)d_ws;
#ifndef DBG_LAST_STEP
#define DBG_LAST_STEP 27
#endif
#if MK_PER_PHASE
    for (int st = 0; st <= DBG_LAST_STEP; ++st) { if ((st % 7) == 3 && ((st / 7) % 3) != 1) continue; a.ph_lo = st; a.ph_hi = st + 1;
        hipLaunchKernelGGL(trunk_fwd, dim3(grid), dim3(NWAVES * 64), LDS_BYTES, stream, a); }
#ifdef DBG_DUMP_OFF
    hipLaunchKernelGGL(dbg_dump, dim3(2048), dim3(256), 0, stream, (const unsigned short*)((const char*)d_ws + (size_t)(DBG_DUMP_OFF)), (float*)d_out, T_ * 1024);
#endif
#else
    a.ph_lo = 0; a.ph_hi = 28;
    hipLaunchKernelGGL(trunk_fwd, dim3(grid), dim3(NWAVES * 64), LDS_BYTES, stream, a);
#endif
}
```
